# Optimizing an MI355X kernel written in HIP

```python
import math
import jax, jax.numpy as jnp
from jax import lax
import numpy as np

D_MODEL = 1024
BATCH = 32
SEQ = 2048
DEPTH = 2
DEC_BATCH = 4
DEC_SEQ = 4096
PAST_LEN = 128

HEAD_DIM = 64
GRID_W = 64
Q_BLOCK = 128
EPS = 1e-6
NEG = -1e30

A_Q_HEADS = 8
A_KV_HEADS = 2
AXIAL_THETA = 10000.0
B_HEADS = 4
LAMBDA_SCALE = 0.1
C_HEADS = 16
C_PATTERNS = ((128, 1), (512, 4), (2048, 16))
ROPE_THETA = 500000.0
ROPE_DIMS = HEAD_DIM // 4

A_Q_W = A_Q_HEADS * HEAD_DIM
A_KV_W = A_KV_HEADS * HEAD_DIM
B_QK_W = B_HEADS * 2 * HEAD_DIM
B_V_W = B_HEADS * 2 * HEAD_DIM
EVEN_MIX_W = A_Q_W + B_V_W
EVEN_SPLITS = (A_Q_W, A_KV_W, A_KV_W, B_QK_W, B_QK_W, B_V_W, EVEN_MIX_W)
EVEN_IN_W = sum(EVEN_SPLITS)
C_W = C_HEADS * HEAD_DIM
ODD_SPLITS = (C_W, C_W, C_W, C_W)
ODD_IN_W = sum(ODD_SPLITS)

kernel_name = "hybrid_gqa_diff_dilated_encoder"


def _split_points(sizes):
    pts, acc = [], 0
    for s in sizes[:-1]:
        acc += s
        pts.append(acc)
    return pts


def rms_norm(x, g):
    x32 = x.astype(jnp.float32)
    y = x32 * lax.rsqrt(jnp.mean(x32 * x32, axis=-1, keepdims=True) + EPS)
    return (y * g.astype(jnp.float32)).astype(x.dtype)


def rotate_half(x):
    x1, x2 = jnp.split(x, 2, axis=-1)
    return jnp.concatenate([-x2, x1], axis=-1)


def rope_angles(pos, n_dims, theta):
    freqs = theta ** (-jnp.arange(0, n_dims, 2, dtype=jnp.float32) / n_dims)
    ang = pos[:, None] * freqs[None, :]
    ang = jnp.concatenate([ang, ang], axis=-1)
    return jnp.cos(ang), jnp.sin(ang)


def apply_rope(x, cos, sin):
    S, n = cos.shape
    shp = (1, S) + (1,) * (x.ndim - 3) + (n,)
    c = cos.reshape(shp).astype(x.dtype)
    s = sin.reshape(shp).astype(x.dtype)
    return x * c + rotate_half(x) * s


def partial_rope(x):
    S = x.shape[1]
    pos = jnp.arange(S, dtype=jnp.float32)
    cos, sin = rope_angles(pos, ROPE_DIMS, ROPE_THETA)
    return jnp.concatenate([apply_rope(x[..., :ROPE_DIMS], cos, sin), x[..., ROPE_DIMS:]], axis=-1)


def axial_rope(x):
    S = x.shape[1]
    rows = S // GRID_W
    row = jnp.broadcast_to(jnp.arange(rows, dtype=jnp.float32)[:, None], (rows, GRID_W)).reshape(-1)
    col = jnp.broadcast_to(jnp.arange(GRID_W, dtype=jnp.float32)[None, :], (rows, GRID_W)).reshape(-1)
    half = HEAD_DIM // 2
    xr = apply_rope(x[..., :half], *rope_angles(row, half, AXIAL_THETA))
    xc = apply_rope(x[..., half:], *rope_angles(col, half, AXIAL_THETA))
    return jnp.concatenate([xr, xc], axis=-1)


def split_q_blocks(q):
    B, S = q.shape[:2]
    return jnp.moveaxis(q.reshape((B, S // Q_BLOCK, Q_BLOCK) + q.shape[2:]), 1, 0)


def merge_q_blocks(o):
    nb, B = o.shape[:2]
    return jnp.moveaxis(o, 0, 1).reshape((B, nb * Q_BLOCK) + o.shape[3:])


def gqa_attention(q, k, v):
    B, S, Hq, D = q.shape
    Hkv = k.shape[2]
    G = Hq // Hkv
    scale = D ** -0.5
    qb = split_q_blocks(q.reshape(B, S, Hkv, G, D))

    def block(qi):
        s = jnp.einsum('bqhgd,bkhd->bhgqk', qi, k, preferred_element_type=jnp.float32) * scale
        p = jax.nn.softmax(s, axis=-1).astype(v.dtype)
        return jnp.einsum('bhgqk,bkhd->bqhgd', p, v)

    return merge_q_blocks(lax.map(block, qb)).reshape(B, S, Hq, D)


def diff_attention(q, k, v, lam):
    D = q.shape[-1]
    scale = D ** -0.5
    qb = split_q_blocks(q)

    def block(qi):
        s = jnp.einsum('bqchd,bkchd->bchqk', qi, k, preferred_element_type=jnp.float32) * scale
        p = jax.nn.softmax(s, axis=-1)
        a = (p[:, 0] - lam * p[:, 1]).astype(v.dtype)
        return jnp.einsum('bhqk,bkhe->bqhe', a, v)

    return merge_q_blocks(lax.map(block, qb))


def band_attention(q, k, v, radius):
    B, N, L, H, D = q.shape
    blk = radius
    nb = -(-L // blk)
    Lp = nb * blk
    scale = D ** -0.5
    qp = jnp.pad(q, ((0, 0), (0, 0), (0, Lp - L), (0, 0), (0, 0)))
    kv_pad = ((0, 0), (0, 0), (blk, Lp - L + blk), (0, 0), (0, 0))
    kb = jnp.pad(k, kv_pad).reshape(B, N, nb + 2, blk, H, D)
    vb = jnp.pad(v, kv_pad).reshape(B, N, nb + 2, blk, H, D)
    kw = jnp.concatenate([kb[:, :, :-2], kb[:, :, 1:-1], kb[:, :, 2:]], axis=3)
    vw = jnp.concatenate([vb[:, :, :-2], vb[:, :, 1:-1], vb[:, :, 2:]], axis=3)
    qb = qp.reshape(B, N, nb, blk, H, D)
    qpos = jnp.arange(nb)[:, None] * blk + jnp.arange(blk)[None, :]
    kpos = (jnp.arange(nb)[:, None] - 1) * blk + jnp.arange(3 * blk)[None, :]
    valid = ((jnp.abs(kpos[:, None, :] - qpos[:, :, None]) <= radius)
             & (kpos[:, None, :] >= 0) & (kpos[:, None, :] < L))
    s = jnp.einsum('bniqhd,bnikhd->bnihqk', qb, kw, preferred_element_type=jnp.float32) * scale
    s = jnp.where(valid[None, None, :, None], s, NEG)
    m = jnp.max(s, axis=-1, keepdims=True)
    e = jnp.exp(s - m)
    den = jnp.sum(e, axis=-1, keepdims=True)
    p = (e / den).astype(v.dtype)
    lse = (jnp.log(den) + m)[..., 0]
    o = jnp.einsum('bnihqk,bnikhd->bniqhd', p, vw).reshape(B, N, Lp, H, D)[:, :, :L]
    lse = jnp.swapaxes(lse, 3, 4).reshape(B, N, Lp, H)[:, :, :L]
    return o, lse


def dilated_branch(q, k, v, window, dilation):
    B, S, H, D = q.shape
    L = S // dilation
    radius = window // (2 * dilation)

    def strided(t):
        return jnp.swapaxes(t.reshape(B, L, dilation, H, D), 1, 2)

    o, lse = band_attention(strided(q), strided(k), strided(v), radius)
    o = jnp.swapaxes(o, 1, 2).reshape(B, S, H, D)
    lse = jnp.swapaxes(lse, 1, 2).reshape(B, S, H)
    return o, lse


def dilated_attention(q, k, v):
    outs, lses = [], []
    for window, dilation in C_PATTERNS:
        o, lse = dilated_branch(q, k, v, window, dilation)
        outs.append(o)
        lses.append(lse)
    w = jax.nn.softmax(jnp.stack(lses, axis=0), axis=0)
    o = jnp.sum(w[..., None] * jnp.stack(outs, axis=0).astype(jnp.float32), axis=0)
    return o.astype(q.dtype)


def even_layer(x, norm_g, w_in, w_out, a_q_norm, a_k_norm, b_q_norm, b_k_norm,
               lambda_q1, lambda_k1, lambda_q2, lambda_k2, b_subln, layer_idx):
    B, S, _ = x.shape
    h = rms_norm(x, norm_g)
    z = h @ w_in
    qa, ka, va, qb, kb, vb, gate = jnp.split(z, _split_points(EVEN_SPLITS), axis=-1)
    qa = axial_rope(rms_norm(qa.reshape(B, S, A_Q_HEADS, HEAD_DIM), a_q_norm))
    ka = axial_rope(rms_norm(ka.reshape(B, S, A_KV_HEADS, HEAD_DIM), a_k_norm))
    va = va.reshape(B, S, A_KV_HEADS, HEAD_DIM)
    oa = gqa_attention(qa, ka, va).reshape(B, S, A_Q_W)
    qb = jnp.swapaxes(qb.reshape(B, S, B_HEADS, 2, HEAD_DIM), 2, 3)
    kb = jnp.swapaxes(kb.reshape(B, S, B_HEADS, 2, HEAD_DIM), 2, 3)
    qb = partial_rope(rms_norm(qb, b_q_norm))
    kb = partial_rope(rms_norm(kb, b_k_norm))
    vb = vb.reshape(B, S, B_HEADS, 2 * HEAD_DIM)
    lambda_init = 0.8 - 0.6 * math.exp(-0.3 * layer_idx)
    f32 = jnp.float32
    lam = (jnp.exp(jnp.sum(lambda_q1.astype(f32) * lambda_k1.astype(f32)))
           - jnp.exp(jnp.sum(lambda_q2.astype(f32) * lambda_k2.astype(f32))) + lambda_init)
    ob = diff_attention(qb, kb, vb, lam)
    ob = (rms_norm(ob, b_subln) * (1.0 - lambda_init)).reshape(B, S, B_V_W)
    mix = jnp.concatenate([oa, ob], axis=-1) * jax.nn.silu(gate)
    return x + mix @ w_out


def odd_layer(x, norm_g, w_in, w_out, c_q_norm, c_k_norm):
    B, S, _ = x.shape
    h = rms_norm(x, norm_g)
    z = h @ w_in
    q, k, v, gate = jnp.split(z, _split_points(ODD_SPLITS), axis=-1)
    q = partial_rope(rms_norm(q.reshape(B, S, C_HEADS, HEAD_DIM), c_q_norm))
    k = partial_rope(rms_norm(k.reshape(B, S, C_HEADS, HEAD_DIM), c_k_norm))
    v = v.reshape(B, S, C_HEADS, HEAD_DIM)
    o = dilated_attention(q, k, v).reshape(B, S, C_W)
    return x + (o * jax.nn.silu(gate)) @ w_out


def trunk(x, even_params, odd_params):
    for l in range(DEPTH):
        if l % 2 == 0:
            x = even_layer(x, *even_params, layer_idx=l)
        else:
            x = odd_layer(x, *odd_params)
    return x


def setup_inputs(seed: int = 0) -> dict:
    key = jax.random.key(seed)
    ks = jax.random.split(key, 20)
    f32 = jnp.float32

    def nrm(k, shape, scale):
        return jax.random.normal(k, shape, f32) * scale

    def gain(k, n):
        return jnp.ones((n,), f32) + 0.02 * jax.random.normal(k, (n,), f32)

    return {
        "x_prompt": nrm(ks[0], (BATCH, SEQ, D_MODEL), 1.0),
        "x_sample": nrm(ks[1], (DEC_BATCH, DEC_SEQ, D_MODEL), 1.0),
        "norm0": gain(ks[2], D_MODEL),
        "w_in0": nrm(ks[3], (D_MODEL, EVEN_IN_W), D_MODEL ** -0.5),
        "w_out0": nrm(ks[4], (EVEN_MIX_W, D_MODEL), EVEN_MIX_W ** -0.5),
        "a_q_norm": gain(ks[5], HEAD_DIM),
        "a_k_norm": gain(ks[6], HEAD_DIM),
        "b_q_norm": gain(ks[7], HEAD_DIM),
        "b_k_norm": gain(ks[8], HEAD_DIM),
        "lambda_q1": nrm(ks[9], (HEAD_DIM,), LAMBDA_SCALE),
        "lambda_k1": nrm(ks[10], (HEAD_DIM,), LAMBDA_SCALE),
        "lambda_q2": nrm(ks[11], (HEAD_DIM,), LAMBDA_SCALE),
        "lambda_k2": nrm(ks[12], (HEAD_DIM,), LAMBDA_SCALE),
        "b_subln": gain(ks[13], 2 * HEAD_DIM),
        "norm1": gain(ks[14], D_MODEL),
        "w_in1": nrm(ks[15], (D_MODEL, ODD_IN_W), D_MODEL ** -0.5),
        "w_out1": nrm(ks[16], (C_W, D_MODEL), C_W ** -0.5),
        "c_q_norm": gain(ks[17], HEAD_DIM),
        "c_k_norm": gain(ks[18], HEAD_DIM),
    }


def reference(x_prompt, x_sample, norm0, w_in0, w_out0, a_q_norm, a_k_norm, b_q_norm, b_k_norm,
              lambda_q1, lambda_k1, lambda_q2, lambda_k2, b_subln, norm1, w_in1, w_out1,
              c_q_norm, c_k_norm):
    even_params = (norm0, w_in0, w_out0, a_q_norm, a_k_norm, b_q_norm, b_k_norm,
                   lambda_q1, lambda_k1, lambda_q2, lambda_k2, b_subln)
    odd_params = (norm1, w_in1, w_out1, c_q_norm, c_k_norm)
    y_prompt = trunk(x_prompt, even_params, odd_params)
    y_sample = trunk(x_sample, even_params, odd_params)
    return (y_prompt, y_sample)
```

```cpp
#include <hip/hip_runtime.h>
#include <hip/hip_cooperative_groups.h>
#include <cstdio>
#include <cstdint>
#include <cmath>
namespace cg = cooperative_groups;
namespace pg8 {
#define PG8_LAS __attribute__((address_space(3)))
typedef unsigned short bf16_t;
typedef _Float16 bf16x8 __attribute__((ext_vector_type(8)));
typedef float f32x4 __attribute__((ext_vector_type(4)));
typedef unsigned u32x4 __attribute__((ext_vector_type(4)));
constexpr int BM = 256, BK = 64, HALF = 128, HTB = HALF * BK * 2  , STAGE_BYTES = 8 * HTB, NXCD = 8, WGM = 8;

__host__ __device__ __forceinline__ int lds_byte(int r, int c) { const int st = (r >> 4) * 2 + (c >> 5), rr = r & 15, cc = c & 31, ob = rr * 64 + cc * 2; return st * 1024 + (ob ^ (((ob >> 9) & 1) << 5)); }
__host__ __device__ __forceinline__ void stage_rc(int b, int& R, int& C) { const int st = b / 1024, sb = b % 1024, swz = sb ^ (((sb >> 9) & 1) << 5); R = (st >> 1) * 16 + swz / 64; C = (st & 1) * 32 + (swz % 64) / 2; }
__host__ __device__ __forceinline__ int perm32(int rho) { const int n = rho >> 4, i = rho & 15; return 8 * (i >> 2) + 4 * n + (i & 3); }

struct Unit { int pm, pn; };
struct Gemm { const bf16_t* A; const bf16_t* Bt; int M, N, K; };

struct StaticOrder {
    int nM, nN, nwg, G, c;
    __host__ __device__ void init(int M, int N, int G_, int c_) { nM = M / BM; nN = N / BM; nwg = nM * nN; G = G_; c = c_; }
    __host__ __device__ bool next(int i, Unit& u) const {
        const long L = (long)i * G + c; if (L >= nwg) return false;
        int wgid = (int)L; { const int q = nwg / NXCD, r = nwg % NXCD, xcd = wgid % NXCD, off = wgid / NXCD; wgid = (xcd < r ? xcd * (q + 1) : r * (q + 1) + (xcd - r) * q) + off; }
        const int nig = WGM * nN, gid = wgid / nig, fm = gid * WGM, gsz = (nM - fm) < WGM ? (nM - fm) : WGM;
        u.pm = fm + ((wgid % nig) % gsz); u.pn = (wgid % nig) / gsz; return true;
    }
    __device__ __forceinline__ void a_ready(const Unit&) const {}
    __device__ __forceinline__ void done(const Unit&) const {}
};
template <class Epi, class Sched, bool ALIGN_EPI = false, bool SP2 = false>
__device__ __forceinline__ void gemm_phase(PG8_LAS unsigned char* lds, const Gemm g, const Sched& S, const Epi& E, int tid_in) {
    int tid_ = tid_in; asm volatile("" : "+v"(tid_));
    const int tid = tid_, wid = __builtin_amdgcn_readfirstlane(tid >> 6), lane = tid & 63, wr = wid >> 2, wc = wid & 3, fr = lane & 15, fq = lane >> 4;
    const int K = g.K, nt = K / BK;
    unsigned voffA[2], voffB[2];
#pragma unroll
    for (int i = 0; i < 2; ++i) { int R, C; stage_rc(tid * 16 + i * 8192, R, C); const int Rb = Epi::PERM ? ((R & ~31) + perm32(R & 31)) : R;
        voffA[i] = (unsigned)(R * K + C) * 2u; voffB[i] = (unsigned)(Rb * K + C) * 2u; }
    const size_t kstep = (size_t)(BK * 2);
    const size_t hstep = (size_t)HALF * K * 2;
    const size_t tstep = 2 * hstep;
    const unsigned ldsw = (unsigned)wid * 1024u;
    const int aoff = lds_byte(wr * 64 + fr, fq * 8), boff = lds_byte(wc * 32 + fr, fq * 8);
#define PG8_SA(b, h) (((b) * 2 + (h)) * HTB)
#define PG8_SB(b, h) ((4 + (b) * 2 + (h)) * HTB)
#define PG8_STAGE(bufoff, gbase, voff) do { _Pragma("unroll") for (int _i = 0; _i < 2; ++_i) \
        __builtin_amdgcn_global_load_lds((const unsigned*)((const char*)(gbase) + (voff)[_i]), (PG8_LAS unsigned*)(lds + (bufoff) + ldsw + _i * 8192), 16, 0, 0); } while (0)
#define PG8_LDA(dst, b, h) do { _Pragma("unroll") for (int m = 0; m < 4; ++m) _Pragma("unroll") for (int k = 0; k < 2; ++k) dst[m][k] = *(const PG8_LAS bf16x8*)(lds + PG8_SA(b, h) + aoff + m * 2048 + k * 1024); } while (0)
#define PG8_LDB(dst, b, h) do { _Pragma("unroll") for (int n = 0; n < 2; ++n) _Pragma("unroll") for (int k = 0; k < 2; ++k) dst[n][k] = *(const PG8_LAS bf16x8*)(lds + PG8_SB(b, h) + boff + n * 2048 + k * 1024); } while (0)
#define PG8_MMA(ai, bj, At, Bt) do { __builtin_amdgcn_s_setprio(1); _Pragma("unroll") for (int m = 0; m < 4; ++m) _Pragma("unroll") for (int n = 0; n < 2; ++n) _Pragma("unroll") for (int k = 0; k < 2; ++k) \
        acc[ai][bj][m][n] = __builtin_amdgcn_mfma_f32_16x16x32_f16(Bt[n][k], At[m][k], acc[ai][bj][m][n], 0, 0, 0); __builtin_amdgcn_s_setprio(0); } while (0)
#define PG8_WAIT_V(n) asm volatile("s_waitcnt vmcnt(" #n ")" ::: "memory")
#define PG8_WAIT_L(n) asm volatile("s_waitcnt lgkmcnt(" #n ")" ::: "memory")
#define PG8_BAR __builtin_amdgcn_s_barrier()
#define PG8_SCHED __builtin_amdgcn_sched_barrier(0)
    Unit cur, nxt; int ui = 0;
    if (!S.next(0, cur)) return;
    f32x4 acc[2][2][4][2];
#pragma unroll
    for (int a = 0; a < 2; ++a)
#pragma unroll
        for (int b = 0; b < 2; ++b)
#pragma unroll
            for (int m = 0; m < 4; ++m)
#pragma unroll
                for (int n = 0; n < 2; ++n) acc[a][b][m][n] = (f32x4){0.f, 0.f, 0.f, 0.f};
    bf16x8 At[4][2], B0[2][2], B1[2][2];
    const char* cA = (const char*)g.A + (size_t)cur.pm * tstep; const char* cB = (const char*)g.Bt + (size_t)cur.pn * tstep;
    S.a_ready(cur);
    if constexpr (SP2) {
        PG8_STAGE(PG8_SB(0, 0), cB, voffB); PG8_STAGE(PG8_SB(0, 1), cB + hstep, voffB); PG8_STAGE(PG8_SA(0, 0), cA, voffA); PG8_STAGE(PG8_SA(0, 1), cA + hstep, voffA);
        if (wr == 1) PG8_BAR;
        PG8_WAIT_V(2); PG8_BAR;
        PG8_STAGE(PG8_SB(1, 0), cB + kstep, voffB); PG8_STAGE(PG8_SA(1, 0), cA + kstep, voffA); PG8_STAGE(PG8_SB(1, 1), cB + hstep + kstep, voffB);
        PG8_WAIT_V(6); PG8_BAR;
    } else {
        PG8_STAGE(PG8_SB(0, 0), cB, voffB); PG8_STAGE(PG8_SA(0, 0), cA, voffA); PG8_STAGE(PG8_SB(0, 1), cB + hstep, voffB); PG8_STAGE(PG8_SA(0, 1), cA + hstep, voffA);
        if (wr == 1) PG8_BAR;
        PG8_WAIT_V(4); PG8_BAR;
        PG8_STAGE(PG8_SB(1, 0), cB + kstep, voffB); PG8_STAGE(PG8_SA(1, 0), cA + kstep, voffA); PG8_STAGE(PG8_SB(1, 1), cB + hstep + kstep, voffB);
        PG8_WAIT_V(6); PG8_BAR;
    }
    for (;;) {
        const bool has_next = S.next(ui + 1, nxt);
        const char* nA = has_next ? (const char*)g.A + (size_t)nxt.pm * tstep : cA; const char* nB = has_next ? (const char*)g.Bt + (size_t)nxt.pn * tstep : cB;
        for (int t = 0; t < nt; t += 2) {
            const bool last = (t == nt - 2);
            const char* a1 = cA + (size_t)(t + 1) * kstep;
            const char* a2 = last ? nA : cA + (size_t)(t + 2) * kstep; const char* b2 = last ? nB : cB + (size_t)(t + 2) * kstep;
            const char* a3 = a2 + kstep; const char* b3 = b2 + kstep;
            if (last && has_next) S.a_ready(nxt);
            if constexpr (SP2) {
            PG8_LDB(B0, 0, 0); PG8_LDB(B1, 0, 1); PG8_SCHED; PG8_LDA(At, 0, 0); PG8_STAGE(PG8_SA(1, 1), a1 + hstep, voffA);
            PG8_WAIT_V(8); PG8_WAIT_L(0); PG8_BAR; PG8_MMA(0, 0, At, B0); PG8_MMA(0, 1, At, B1); PG8_BAR; PG8_SCHED;
            PG8_LDA(At, 0, 1); PG8_STAGE(PG8_SB(0, 0), b2, voffB); PG8_STAGE(PG8_SB(0, 1), b2 + hstep, voffB); PG8_STAGE(PG8_SA(0, 0), a2, voffA);
            PG8_WAIT_V(8); PG8_WAIT_L(0); PG8_BAR; PG8_MMA(1, 0, At, B0); PG8_MMA(1, 1, At, B1); PG8_BAR; PG8_SCHED;
            PG8_LDB(B0, 1, 0); PG8_LDB(B1, 1, 1); PG8_SCHED; PG8_LDA(At, 1, 0); PG8_STAGE(PG8_SA(0, 1), a2 + hstep, voffA);
            PG8_WAIT_V(8); PG8_WAIT_L(0); PG8_BAR; PG8_MMA(0, 0, At, B0); PG8_MMA(0, 1, At, B1); PG8_BAR; PG8_SCHED;
            PG8_LDA(At, 1, 1); PG8_STAGE(PG8_SB(1, 0), b3, voffB); PG8_STAGE(PG8_SB(1, 1), b3 + hstep, voffB); PG8_STAGE(PG8_SA(1, 0), a3, voffA);
            PG8_WAIT_V(8); PG8_WAIT_L(0); PG8_BAR; PG8_MMA(1, 0, At, B0); PG8_MMA(1, 1, At, B1); PG8_BAR; PG8_SCHED;
            } else {
            PG8_LDB(B0, 0, 0); PG8_SCHED; PG8_LDA(At, 0, 0); PG8_STAGE(PG8_SA(1, 1), a1 + hstep, voffA);
            PG8_WAIT_L(8); PG8_BAR; PG8_WAIT_L(0); PG8_MMA(0, 0, At, B0); PG8_BAR; PG8_SCHED;
            PG8_LDB(B1, 0, 1); PG8_STAGE(PG8_SB(0, 0), b2, voffB);
            PG8_BAR; PG8_WAIT_L(0); PG8_MMA(0, 1, At, B1); PG8_BAR;
            PG8_LDA(At, 0, 1); PG8_STAGE(PG8_SA(0, 0), a2, voffA);
            PG8_BAR; PG8_WAIT_L(0); PG8_MMA(1, 0, At, B0); PG8_BAR; PG8_SCHED;
            PG8_STAGE(PG8_SB(0, 1), b2 + hstep, voffB);
            PG8_WAIT_V(6); PG8_BAR; PG8_MMA(1, 1, At, B1); PG8_BAR;
            PG8_LDB(B0, 1, 0); PG8_SCHED; PG8_LDA(At, 1, 0); PG8_STAGE(PG8_SA(0, 1), a2 + hstep, voffA);
            PG8_WAIT_L(8); PG8_BAR; PG8_WAIT_L(0); PG8_MMA(0, 0, At, B0); PG8_BAR; PG8_SCHED;
            PG8_LDB(B1, 1, 1); PG8_STAGE(PG8_SB(1, 0), b3, voffB);
            PG8_BAR; PG8_WAIT_L(0); PG8_MMA(0, 1, At, B1); PG8_BAR;
            PG8_LDA(At, 1, 1); PG8_STAGE(PG8_SA(1, 0), a3, voffA);
            PG8_BAR; PG8_WAIT_L(0); PG8_MMA(1, 0, At, B0); PG8_BAR; PG8_SCHED;
            PG8_STAGE(PG8_SB(1, 1), b3 + hstep, voffB);
            PG8_WAIT_V(6); PG8_BAR; PG8_MMA(1, 1, At, B1); PG8_BAR;
            }
        }
        if constexpr (ALIGN_EPI) { if (wr == 0) PG8_BAR; }
        if constexpr (!Epi::AFTER_DRAIN) { E(acc, cur, wr, wc, fr, fq); S.done(cur); }
        if (!has_next) break;
#pragma unroll
        for (int a = 0; a < 2; ++a)
#pragma unroll
            for (int b = 0; b < 2; ++b)
#pragma unroll
                for (int m = 0; m < 4; ++m)
#pragma unroll
                    for (int n = 0; n < 2; ++n) acc[a][b][m][n] = (f32x4){0.f, 0.f, 0.f, 0.f};
        cur = nxt; cA = nA; cB = nB; ++ui;
        if constexpr (ALIGN_EPI) { if (wr == 1) PG8_BAR; }
    }
    PG8_WAIT_V(0);
    if constexpr (!ALIGN_EPI) { if (wr == 0) PG8_BAR; }
    PG8_BAR;
    if constexpr (Epi::AFTER_DRAIN) { E.fused(acc, cur, wr, wc, fr, fq, lds, wid, lane); S.done(cur); }
#undef PG8_SA
#undef PG8_SB
#undef PG8_STAGE
#undef PG8_LDA
#undef PG8_LDB
#undef PG8_MMA
#undef PG8_WAIT_V
#undef PG8_WAIT_L
#undef PG8_BAR
#undef PG8_SCHED
}
}

#define LAS __attribute__((address_space(3)))
typedef _Float16 h16;
typedef h16 h16x2 __attribute__((ext_vector_type(2)));
typedef h16 h16x4 __attribute__((ext_vector_type(4)));
typedef h16 h16x8 __attribute__((ext_vector_type(8)));
typedef float f32x4 __attribute__((ext_vector_type(4)));
typedef float f32x16 __attribute__((ext_vector_type(16)));
typedef unsigned u32x4 __attribute__((ext_vector_type(4)));
typedef unsigned u32x2 __attribute__((ext_vector_type(2)));

constexpr int TP = 65536, TS = 16384, TT = TP + TS, DM = 1024, N0 = 3328, N1 = 4096;
constexpr float EPS = 1e-6f;
constexpr float QSCALE = 0.125f * 1.4426950408889634f;
constexpr size_t MiB = 1u << 20;
constexpr size_t WS_CTL = 0, WS_BAR = 4096;
constexpr size_t WS_TAXC = 1 * MiB, WS_TAXS = 1 * MiB + 8192, WS_TPRC = 1 * MiB + 65536, WS_TPRS = 1 * MiB + 65536 + 131072;
constexpr size_t WS_SSQ0 = 2 * MiB, WS_SSQ1 = 2 * MiB + 512 * 1024;
constexpr size_t WS_WIN0 = 3 * MiB, WS_WOUT0 = 10 * MiB, WS_WIN1 = 12 * MiB, WS_WOUT1 = 20 * MiB;
constexpr size_t WS_XH = 24 * MiB, WS_MIX = 184 * MiB, WS_Z = 344 * MiB, WS_STASH = 984 * MiB, WS_END = 1008 * MiB;
constexpr int LDS_BYTES = 163840;
constexpr int NTHREADS = 512;

struct Params {
    const float* in[19];
    float* out;
    unsigned char* ws;
    int ph_lo, ph_hi;
    double frq[24];
};

__device__ __forceinline__ float wave_sum(float v) {
#pragma unroll
    for (int o = 32; o; o >>= 1) v += __shfl_xor(v, o);
    return v;
}
__device__ __forceinline__ int opaque_lane() { int l; asm volatile("v_mbcnt_lo_u32_b32 %0, -1, 0\n\tv_mbcnt_hi_u32_b32 %0, -1, %0" : "=v"(l)); return l; }
__device__ __forceinline__ float max3f(float a, float b, float c) { float r; asm("v_max3_f32 %0, %1, %2, %3" : "=v"(r) : "v"(a), "v"(b), "v"(c)); return r; }
__device__ __forceinline__ float max2f(float a, float b) { float r; asm("v_max_f32_e32 %0, %1, %2" : "=v"(r) : "v"(a), "v"(b)); return r; }
__device__ __forceinline__ float swapmax32(float v) {
    auto rr = __builtin_amdgcn_permlane32_swap(__float_as_uint(v), __float_as_uint(v), false, false);
    return max2f(__uint_as_float(rr[0]), __uint_as_float(rr[1]));
}
__device__ __forceinline__ float swapsum32(float v) {
    auto rr = __builtin_amdgcn_permlane32_swap(__float_as_uint(v), __float_as_uint(v), false, false);
    return __uint_as_float(rr[0]) + __uint_as_float(rr[1]);
}
__device__ __forceinline__ unsigned zo(int slot, int row) { return ((unsigned)slot * (unsigned)TT + (unsigned)row) * 64u; }
__device__ __forceinline__ float fexp2(float x) { return __builtin_amdgcn_exp2f(x); }
__device__ __forceinline__ unsigned pk2(float a, float b) { h16x2 v = {(h16)a, (h16)b}; return __builtin_bit_cast(unsigned, v); }
__device__ __forceinline__ h16x4 tr16(LAS const unsigned char* p) {
    typedef short v4i16_t __attribute__((ext_vector_type(4)));
    return __builtin_bit_cast(h16x4, __builtin_amdgcn_ds_read_tr16_b64_v4i16((LAS v4i16_t*)p));
}
__device__ __forceinline__ f32x16 mfma32(h16x8 a, h16x8 b, f32x16 c) { return __builtin_amdgcn_mfma_f32_32x32x16_f16(a, b, c, 0, 0, 0); }

__device__ __forceinline__ void p0_phase(const Params& P, LAS unsigned char* lds, int tid_in) {
    int tid_ = tid_in; asm volatile("" : "+v"(tid_));
    const int tid = tid_, lane = tid & 63, wave = tid >> 6, bid = blockIdx.x, nb = gridDim.x;
    unsigned char* ws = P.ws;
    LAS h16* ts = (LAS h16*)lds;
    for (int tile = bid; tile < 2368; tile += nb) {
        const int ntile = tile >> 4, kt = tile & 15;
        const float* w; const float* g; h16* wt; int N, nt, perm;
        if (ntile < 52)       { w = P.in[3];  g = P.in[2];  wt = (h16*)(ws + WS_WIN0);  N = N0;   nt = ntile;       perm = 1; }
        else if (ntile < 68)  { w = P.in[4];  g = nullptr;  wt = (h16*)(ws + WS_WOUT0); N = 1024; nt = ntile - 52;  perm = 0; }
        else if (ntile < 132) { w = P.in[15]; g = P.in[14]; wt = (h16*)(ws + WS_WIN1);  N = N1;   nt = ntile - 68;  perm = 1; }
        else                  { w = P.in[16]; g = nullptr;  wt = (h16*)(ws + WS_WOUT1); N = 1024; nt = ntile - 132; perm = 0; }
        const int k0 = kt * 64, n0 = nt * 64;
#pragma unroll
        for (int i = 0; i < 8; ++i) {
            const int kk = wave + 8 * i;
            float v = w[(size_t)(k0 + kk) * N + n0 + lane];
            if (g) v *= g[k0 + kk];
            ts[kk * 66 + lane] = (h16)v;
        }
        __syncthreads();
#pragma unroll
        for (int i = 0; i < 8; ++i) {
            const int nn = wave + 8 * i;
            const int c = n0 + nn;
            int pr = c;
            if (perm) { const int t256 = c >> 8, lc = c & 255, hh = lc >> 6, d = lc & 63; pr = (t256 << 8) + 128 * (d >> 5) + 32 * hh + (d & 31); }
            wt[(size_t)pr * 1024 + k0 + lane] = ts[lane * 66 + nn];
        }
        __syncthreads();
    }
    h16* XH = (h16*)(ws + WS_XH);
    float* ssq0 = (float*)(ws + WS_SSQ0);
    float* ssq1 = (float*)(ws + WS_SSQ1);
    for (int row0 = bid * 8 + wave; row0 < TT; row0 += nb * 32) {
        f32x4 v[4][4];
#pragma unroll
        for (int t = 0; t < 4; ++t) {
            const int row = row0 + t * nb * 8;
            if (row < TT) {
                const float* src = row < TP ? P.in[0] + (size_t)row * 1024 : P.in[1] + (size_t)(row - TP) * 1024;
#pragma unroll
                for (int i = 0; i < 4; ++i) v[t][i] = __builtin_nontemporal_load((const f32x4*)(src + i * 256 + lane * 4));
            }
        }
#pragma unroll
        for (int t = 0; t < 4; ++t) {
            const int row = row0 + t * nb * 8;
            if (row < TT) {
                h16* dst = XH + (size_t)row * 1024;
                float ss = 0.f;
#pragma unroll
                for (int i = 0; i < 4; ++i) {
                    ss += v[t][i][0] * v[t][i][0] + v[t][i][1] * v[t][i][1] + v[t][i][2] * v[t][i][2] + v[t][i][3] * v[t][i][3];
                    u32x2 pk; pk[0] = pk2(v[t][i][0], v[t][i][1]); pk[1] = pk2(v[t][i][2], v[t][i][3]);
                    *(u32x2*)(dst + i * 256 + lane * 4) = pk;
                }
                ss = wave_sum(ss);
                if (lane == 0) ssq0[row] = ss;
            }
        }
    }
    const int gtid = bid * NTHREADS + tid, gn = nb * NTHREADS;
    for (int i = gtid; i < TT; i += gn) ssq1[i] = 0.f;
    if (bid == 0 && wave == 0) {
        float a = P.in[9][lane] * P.in[10][lane], b = P.in[11][lane] * P.in[12][lane];
        a = wave_sum(a); b = wave_sum(b);
        if (lane == 0) ((float*)(ws + WS_CTL))[0] = __expf(a) - __expf(b) + 0.2f;
    }
}

__device__ __forceinline__ float partner16(float x) {
    auto r = __builtin_amdgcn_permlane16_swap(__float_as_uint(x), __float_as_uint(x), false, false);
    return __uint_as_float(r[0] == __float_as_uint(x) ? r[1] : r[0]);
}
__device__ __forceinline__ float partner32(float x) {
    auto r = __builtin_amdgcn_permlane32_swap(__float_as_uint(x), __float_as_uint(x), false, false);
    return __uint_as_float(r[0] == __float_as_uint(x) ? r[1] : r[0]);
}
__device__ __forceinline__ float sum16(float x) { auto r = __builtin_amdgcn_permlane16_swap(__float_as_uint(x), __float_as_uint(x), false, false); return __uint_as_float(r[0]) + __uint_as_float(r[1]); }
__device__ __forceinline__ float sum32(float x) { auto r = __builtin_amdgcn_permlane32_swap(__float_as_uint(x), __float_as_uint(x), false, false); return __uint_as_float(r[0]) + __uint_as_float(r[1]); }

struct EpiIn {
    static constexpr bool PERM = true, AFTER_DRAIN = false;
    h16* Z; int ldz; int layer; const float* ssq;
    const float* g0; const float* g1; const float* g2; const float* g3;
    __device__ __forceinline__ void operator()(const pg8::f32x4 (&acc)[2][2][4][2], const pg8::Unit& u, int wr, int wc, int fr, int fq) const {
        const int gh = u.pn * 4 + wc;
        int type; const float* gain = g0; float qs = 1.f;
        if (layer == 0) {
            if (gh < 8) { type = 2; gain = g0; qs = QSCALE; }
            else if (gh < 10) { type = 2; gain = g1; }
            else if (gh < 12) { type = 0; }
            else if (gh < 20) { type = 1; gain = g2; qs = QSCALE; }
            else if (gh < 28) { type = 1; gain = g3; }
            else if (gh < 36) { type = 0; }
            else { type = 3; }
        } else {
            if (gh < 16) { type = 1; gain = g2; qs = QSCALE; }
            else if (gh < 32) { type = 1; gain = g3; }
            else if (gh < 48) { type = 0; }
            else { type = 3; }
        }
        type = __builtin_amdgcn_readfirstlane(type);
        constexpr float PRF[8] = {1.591549431e-01f, 3.086376340e-02f, 5.985185713e-03f, 1.160663641e-03f, 2.250790790e-04f, 4.364795279e-05f, 8.464330808e-06f, 1.641426263e-06f};
        constexpr float AXF[16] = {1.591549431e-01f, 8.949940161e-02f, 5.032921210e-02f, 2.830219583e-02f, 1.591549431e-02f, 8.949940161e-03f, 5.032921210e-03f, 2.830219583e-03f,
                                   1.591549431e-03f, 8.949940161e-04f, 5.032921210e-04f, 2.830219583e-04f, 1.591549431e-04f, 8.949940161e-05f, 5.032921210e-05f, 2.830219583e-05f};
        float gv[2][8], frev[8];
#pragma unroll
        for (int e = 0; e < 8; ++e) frev[e] = type == 1 ? PRF[e] : ((fq & 1) ? AXF[8 + e] : AXF[e]);
#pragma unroll
        for (int bj = 0; bj < 2; ++bj)
#pragma unroll
            for (int e = 0; e < 8; ++e) gv[bj][e] = (type == 1 || type == 2) ? gain[32 * bj + 8 * fq + e] * qs : 1.f;
        h16* zcol = Z + 8 * fq;
        float rsv[2][4];
#pragma unroll
        for (int ai = 0; ai < 2; ++ai)
#pragma unroll
            for (int m = 0; m < 4; ++m) rsv[ai][m] = ssq[u.pm * 256 + ai * 128 + wr * 64 + m * 16 + fr];
#pragma unroll
        for (int ai = 0; ai < 2; ++ai)
#pragma unroll
            for (int m = 0; m < 4; ++m) {
                const int row = u.pm * 256 + ai * 128 + wr * 64 + m * 16 + fr;
                const float rs = __builtin_amdgcn_rsqf(rsv[ai][m] * (1.f / 1024.f) + EPS);
                float v[2][8];
#pragma unroll
                for (int bj = 0; bj < 2; ++bj)
#pragma unroll
                    for (int n = 0; n < 2; ++n)
#pragma unroll
                        for (int e = 0; e < 4; ++e) v[bj][4 * n + e] = acc[ai][bj][m][n][e] * rs;
                if (type == 1 || type == 2) {
                    float ss = 0.f;
#pragma unroll
                    for (int bj = 0; bj < 2; ++bj)
#pragma unroll
                        for (int e = 0; e < 8; ++e) ss += v[bj][e] * v[bj][e];
                    ss = sum32(sum16(ss));
                    const float rn = __builtin_amdgcn_rsqf(ss * (1.f / 64.f) + EPS);
#pragma unroll
                    for (int bj = 0; bj < 2; ++bj)
#pragma unroll
                        for (int e = 0; e < 8; ++e) v[bj][e] *= rn * gv[bj][e];
                    const int s = row < TP ? (row & 2047) : (row & 4095);
                    if (type == 1) {
                        const float pos = (float)s;
                        const float sg = fq == 0 ? -1.f : 1.f;
#pragma unroll
                        for (int e = 0; e < 8; ++e) {
                            const float pr = partner16(v[0][e]);
                            const float ang = __builtin_amdgcn_fractf(pos * frev[e]);
                            const float cs = __builtin_amdgcn_cosf(ang), sn = __builtin_amdgcn_sinf(ang);
                            const float rv = v[0][e] * cs + sg * pr * sn;
                            v[0][e] = fq < 2 ? rv : v[0][e];
                        }
                    } else {
                        const float sg = fq < 2 ? -1.f : 1.f;
#pragma unroll
                        for (int bj = 0; bj < 2; ++bj) {
                            const float pos = (float)(bj == 0 ? (s >> 6) : (s & 63));
#pragma unroll
                            for (int e = 0; e < 8; ++e) {
                                const float pr = partner32(v[bj][e]);
                                const float ang = __builtin_amdgcn_fractf(pos * frev[e]);
                                const float cs = __builtin_amdgcn_cosf(ang), sn = __builtin_amdgcn_sinf(ang);
                                v[bj][e] = v[bj][e] * cs + sg * pr * sn;
                            }
                        }
                    }
                } else if (type == 3) {
#pragma unroll
                    for (int bj = 0; bj < 2; ++bj)
#pragma unroll
                        for (int e = 0; e < 8; ++e) { const float x = v[bj][e]; v[bj][e] = x * __builtin_amdgcn_rcpf(1.f + fexp2(-1.4426950408889634f * x)); }
                }
                h16* rowp = zcol + zo(gh, row);
#pragma unroll
                for (int bj = 0; bj < 2; ++bj) {
                    u32x4 w; w[0] = pk2(v[bj][0], v[bj][1]); w[1] = pk2(v[bj][2], v[bj][3]); w[2] = pk2(v[bj][4], v[bj][5]); w[3] = pk2(v[bj][6], v[bj][7]);
                    *(u32x4*)(rowp + 32 * bj) = w;
                }
            }
    }
};

struct EpiOut0 {
    static constexpr bool PERM = true, AFTER_DRAIN = false;
    const float* xp; const float* xs; h16* X1; float* ssq1;
    __device__ __forceinline__ void operator()(const pg8::f32x4 (&acc)[2][2][4][2], const pg8::Unit& u, int wr, int wc, int fr, int fq) const {
        const int col0 = u.pn * 256 + wc * 32 + 8 * fq;
#pragma unroll
        for (int ai = 0; ai < 2; ++ai)
#pragma unroll
            for (int m = 0; m < 4; ++m) {
                const int row = u.pm * 256 + ai * 128 + wr * 64 + m * 16 + fr;
                const float* xr = row < TP ? xp + (size_t)row * 1024 : xs + (size_t)(row - TP) * 1024;
                float ss = 0.f;
#pragma unroll
                for (int bj = 0; bj < 2; ++bj) {
                    const int c = col0 + 128 * bj;
                    const f32x4 a0 = __builtin_nontemporal_load((const f32x4*)(xr + c)) + acc[ai][bj][m][0];
                    const f32x4 a1 = __builtin_nontemporal_load((const f32x4*)(xr + c + 4)) + acc[ai][bj][m][1];
                    ss += a0[0] * a0[0] + a0[1] * a0[1] + a0[2] * a0[2] + a0[3] * a0[3] + a1[0] * a1[0] + a1[1] * a1[1] + a1[2] * a1[2] + a1[3] * a1[3];
                    u32x4 w; w[0] = pk2(a0[0], a0[1]); w[1] = pk2(a0[2], a0[3]); w[2] = pk2(a1[0], a1[1]); w[3] = pk2(a1[2], a1[3]);
                    *(u32x4*)(X1 + (size_t)row * 1024 + c) = w;
                }
                ss += __shfl_xor(ss, 16); ss += __shfl_xor(ss, 32);
                if (fq == 0) atomicAdd(ssq1 + row, ss);
            }
    }
};

struct EpiOut1 {
    static constexpr bool PERM = true, AFTER_DRAIN = false;
    const h16* X1; float* out;
    __device__ __forceinline__ void operator()(const pg8::f32x4 (&acc)[2][2][4][2], const pg8::Unit& u, int wr, int wc, int fr, int fq) const {
        const int col0 = u.pn * 256 + wc * 32 + 8 * fq;
#pragma unroll
        for (int ai = 0; ai < 2; ++ai)
#pragma unroll
            for (int m = 0; m < 4; ++m) {
                const int row = u.pm * 256 + ai * 128 + wr * 64 + m * 16 + fr;
#pragma unroll
                for (int bj = 0; bj < 2; ++bj) {
                    const int c = col0 + 128 * bj;
                    const h16x8 xv = *(const h16x8*)(X1 + (size_t)row * 1024 + c);
                    f32x4 a0 = acc[ai][bj][m][0], a1 = acc[ai][bj][m][1];
#pragma unroll
                    for (int e = 0; e < 4; ++e) { a0[e] += (float)xv[e]; a1[e] += (float)xv[4 + e]; }
                    __builtin_nontemporal_store(a0, (f32x4*)(out + (size_t)row * 1024 + c));
                    __builtin_nontemporal_store(a1, (f32x4*)(out + (size_t)row * 1024 + c + 4));
                }
            }
    }
};

template <int DV, int EXP>
__device__ __forceinline__ void dense_tile(LAS const unsigned char* Kb, LAS const unsigned char* Vb, const h16x8 (&qf)[4], f32x16 (&o)[DV / 32], float& m, float& l, int lane) {
    constexpr int VP = (DV == 64) ? 192 : 320;
    const int r = lane & 31, h = lane >> 5;
    f32x16 st0, st1;
    const float base = m > -1e29f ? m : 0.f;
#pragma unroll
    for (int i = 0; i < 16; ++i) { st0[i] = -base; st1[i] = -base; }
    LAS const unsigned char* kp = Kb + r * 144 + h * 16;
#pragma unroll
    for (int ks = 0; ks < 4; ++ks) {
        const h16x8 a0 = *(LAS const h16x8*)(kp + ks * 32);
        const h16x8 a1 = *(LAS const h16x8*)(kp + 32 * 144 + ks * 32);
        st0 = mfma32(a0, qf[ks], st0);
        st1 = mfma32(a1, qf[ks], st1);
    }
#ifdef MK_SCHED_FENCE
    __builtin_amdgcn_sched_barrier(0);
#endif
    if (EXP != 1) {
        float ta = max3f(st0[0], st0[1], st1[0]), tb = max3f(st0[2], st0[3], st1[1]);
        ta = max3f(ta, st1[2], st1[3]);
#pragma unroll
        for (int i = 4; i < 16; i += 4) { ta = max3f(ta, st0[i], st0[i + 1]); tb = max3f(tb, st0[i + 2], st0[i + 3]); ta = max3f(ta, st1[i], st1[i + 1]); tb = max3f(tb, st1[i + 2], st1[i + 3]); }
        const float tm = swapmax32(max2f(ta, tb));
        const float mrel = m - base;
        const float mn = max2f(tm, mrel);
        m = base + mn;
        float rs = 0.f;
        const float alpha = fexp2(mrel - mn);
#pragma unroll
        for (int i = 0; i < 16; ++i) { st0[i] = fexp2(st0[i] - mn); st1[i] = fexp2(st1[i] - mn); rs += st0[i] + st1[i]; }
        l = l * alpha + rs;
        if (__builtin_amdgcn_ballot_w64(mn != 0.f) != 0) {
#pragma unroll
            for (int db = 0; db < DV / 32; ++db)
#pragma unroll
                for (int i = 0; i < 16; ++i) o[db][i] *= alpha;
        }
    } else { l += 1.f; }
    h16x8 pf[4];
#pragma unroll
    for (int j = 0; j < 8; ++j) { pf[0][j] = (h16)st0[j]; pf[1][j] = (h16)st0[8 + j]; pf[2][j] = (h16)st1[j]; pf[3][j] = (h16)st1[8 + j]; }
    if (EXP == 3) { o[0][0] += (float)pf[0][0] + (float)pf[1][1] + (float)pf[2][2] + (float)pf[3][3]; return; }
    const int i16 = r & 15, q = i16 >> 2, p = i16 & 3, ch = r >> 4;
    LAS const unsigned char* vp = Vb + (4 * h + q) * VP + (16 * ch + 4 * p) * 2;
#ifdef MK_SCHED_FENCE
    __builtin_amdgcn_sched_barrier(0);
#endif
#pragma unroll
    for (int db = 0; db < DV / 32; ++db)
#pragma unroll
        for (int kk = 0; kk < 4; ++kk) {
            const h16x4 lo = tr16(vp + (16 * kk) * VP + db * 64);
            const h16x4 hi = tr16(vp + (16 * kk + 8) * VP + db * 64);
            const h16x8 vf = {lo[0], lo[1], lo[2], lo[3], hi[0], hi[1], hi[2], hi[3]};
            o[db] = mfma32(vf, pf[kk], o[db]);
            if (DV == 128 && kk == 3) __builtin_amdgcn_sched_barrier(0);
        }
}

template <int EXP>
__device__ __forceinline__ void dense_tile_h(LAS const unsigned char* Kb, LAS const unsigned char* Vb, const h16x8 (&qf)[4], f32x16 (&o)[4], float& m, float& l, int lane) {
    constexpr int VP = 320;
    const int r = lane & 31, h = lane >> 5;
    const int i16 = r & 15, q = i16 >> 2, p = i16 & 3, ch = r >> 4;
    LAS const unsigned char* vp = Vb + (4 * h + q) * VP + (16 * ch + 4 * p) * 2;
    LAS const unsigned char* kp = Kb + r * 144 + h * 16;
    const float base = m > -1e29f ? m : 0.f;
    f32x16 sth[2];
#pragma unroll
    for (int kbh = 0; kbh < 2; ++kbh) {
#pragma unroll
        for (int i = 0; i < 16; ++i) sth[kbh][i] = -base;
#pragma unroll
        for (int ks = 0; ks < 4; ++ks) sth[kbh] = mfma32(*(LAS const h16x8*)(kp + kbh * 32 * 144 + ks * 32), qf[ks], sth[kbh]);
    }
#pragma unroll
    for (int kbh = 0; kbh < 2; ++kbh) {
        f32x16& st = sth[kbh];
        float tm = max3f(st[0], st[1], st[2]);
#pragma unroll
        for (int i = 3; i < 15; i += 2) tm = max3f(tm, st[i], st[i + 1]);
        tm = swapmax32(max2f(tm, st[15]));
        const float mrel = m - base;
        const float mn = max2f(tm, mrel);
        m = base + mn;
        const float alpha = fexp2(mrel - mn);
        float rs = 0.f;
#pragma unroll
        for (int i = 0; i < 16; ++i) { st[i] = fexp2(st[i] - mn); rs += st[i]; }
        l = l * alpha + rs;
        if (__builtin_amdgcn_ballot_w64(alpha != 1.f) != 0) {
#pragma unroll
            for (int db = 0; db < 4; ++db)
#pragma unroll
                for (int i = 0; i < 16; ++i) o[db][i] *= alpha;
        }
        h16x8 pf[2];
#pragma unroll
        for (int j = 0; j < 8; ++j) { pf[0][j] = (h16)st[j]; pf[1][j] = (h16)st[8 + j]; }
#pragma unroll
        for (int db = 0; db < 4; ++db)
#pragma unroll
            for (int s2 = 0; s2 < 2; ++s2) {
                const int kk = 2 * kbh + s2;
                const h16x4 lo = tr16(vp + (16 * kk) * VP + db * 64);
                const h16x4 hi = tr16(vp + (16 * kk + 8) * VP + db * 64);
                const h16x8 vf = {lo[0], lo[1], lo[2], lo[3], hi[0], hi[1], hi[2], hi[3]};
                o[db] = mfma32(vf, pf[s2], o[db]);
            }
    }
}

template <int DV, int NMAP, int EXP>
__device__ __forceinline__ void dense_unit(const h16* __restrict__ Z, h16* __restrict__ MIX, int tseq, int S, int qb, int qcol, int kcol, int vcol, int ocol, int gcol,
                                           float lam, const float* __restrict__ subln, LAS unsigned char* lds, int tid_in, float* dbg = nullptr) {
    constexpr int VP = (DV == 64) ? 192 : 320;
    constexpr int KBB = 64 * 144, VBB = 64 * VP, NV = DV / 64;
    int tid_ = tid_in * 64 + opaque_lane();
    const int tid = tid_, lane = tid & 63, wave = tid >> 6, r = lane & 31, h = lane >> 5;
    const int tq = tseq + qb * 256 + wave * 32 + r;
    const int NT = S >> 6;
    LAS h16x8* stl = (LAS h16x8*)(lds + 2 * KBB + 2 * VBB + wave * 8192) + lane;
    const int kkey = tid >> 3, kch = tid & 7;
    const int vkey = (DV == 64) ? (tid >> 3) : (tid >> 4), vch = (DV == 64) ? (tid & 7) : (tid & 15);
#pragma unroll 1
    for (int mp = 0; mp < NMAP; ++mp) {
        h16x8 qf[4];
        {
            const unsigned qoff = zo((qcol >> 6) + mp, tq) + 8 * h;
#pragma unroll
            for (int ks = 0; ks < 4; ++ks) qf[ks] = *(const h16x8*)(Z + (qoff + 16 * ks));
        }
        f32x16 o[DV / 32];
#pragma unroll
        for (int db = 0; db < DV / 32; ++db)
#pragma unroll
            for (int i = 0; i < 16; ++i) o[db][i] = 0.f;
        float m = -1e30f, l = 0.f;
        const unsigned koff = zo((kcol >> 6) + mp, tseq + kkey) + kch * 8;
        const unsigned voff = zo((vcol >> 6) + (vch >> 3), tseq + vkey) + (vch & 7) * 8;
        u32x4 kr, vr[NV];
        kr = *(const u32x4*)(Z + koff);
#pragma unroll
        for (int i = 0; i < NV; ++i) vr[i] = *(const u32x4*)(Z + (voff + (unsigned)(32 * i) * 64u));
        __syncthreads();
        *(LAS u32x4*)(lds + kkey * 144 + kch * 16) = kr;
#pragma unroll
        for (int i = 0; i < NV; ++i) *(LAS u32x4*)(lds + 2 * KBB + (vkey + 32 * i) * VP + vch * 16) = vr[i];
        __syncthreads();
        if (EXP == 0) {
            u32x4 kr2, vr2[NV];
            asm volatile("" ::: "memory");
            kr = *(const u32x4*)(Z + (koff + 64u * 64u));
#pragma unroll
            for (int i = 0; i < NV; ++i) vr[i] = *(const u32x4*)(Z + (voff + (unsigned)(64 + 32 * i) * 64u));
#pragma unroll 1
            for (int j = 0; j < NT; j += 2) {
                if (j + 2 < NT) {
                    kr2 = *(const u32x4*)(Z + (koff + (unsigned)(64 * (j + 2)) * 64u));
#pragma unroll
                    for (int i = 0; i < NV; ++i) vr2[i] = *(const u32x4*)(Z + (voff + (unsigned)(64 * (j + 2) + 32 * i) * 64u));
                }
                if constexpr (DV == 128) dense_tile_h<EXP>(lds, lds + 2 * KBB, qf, o, m, l, lane); else dense_tile<DV, EXP>(lds, lds + 2 * KBB, qf, o, m, l, lane);
                *(LAS u32x4*)(lds + KBB + kkey * 144 + kch * 16) = kr;
#pragma unroll
                for (int i = 0; i < NV; ++i) *(LAS u32x4*)(lds + 2 * KBB + VBB + (vkey + 32 * i) * VP + vch * 16) = vr[i];
                __syncthreads();
                if (j + 3 < NT) {
                    kr = *(const u32x4*)(Z + (koff + (unsigned)(64 * (j + 3)) * 64u));
#pragma unroll
                    for (int i = 0; i < NV; ++i) vr[i] = *(const u32x4*)(Z + (voff + (unsigned)(64 * (j + 3) + 32 * i) * 64u));
                }
                if constexpr (DV == 128) dense_tile_h<EXP>(lds + KBB, lds + 2 * KBB + VBB, qf, o, m, l, lane); else dense_tile<DV, EXP>(lds + KBB, lds + 2 * KBB + VBB, qf, o, m, l, lane);
                if (j + 2 < NT) {
                    *(LAS u32x4*)(lds + kkey * 144 + kch * 16) = kr2;
#pragma unroll
                    for (int i = 0; i < NV; ++i) *(LAS u32x4*)(lds + 2 * KBB + (vkey + 32 * i) * VP + vch * 16) = vr2[i];
                }
                __syncthreads();
            }
        } else {
#pragma unroll 1
        for (int j = 0; j < NT; ++j) {
            const int cur = j & 1;
            if (EXP != 2 && j + 1 < NT) {
                kr = *(const u32x4*)(Z + (koff + (unsigned)(64 * (j + 1)) * 64u));
#pragma unroll
                for (int i = 0; i < NV; ++i) vr[i] = *(const u32x4*)(Z + (voff + (unsigned)(64 * (j + 1) + 32 * i) * 64u));
            }
            dense_tile<DV, EXP>(lds + cur * KBB, lds + 2 * KBB + cur * VBB, qf, o, m, l, lane);
            if (EXP != 2 && j + 1 < NT) {
                *(LAS u32x4*)(lds + (cur ^ 1) * KBB + kkey * 144 + kch * 16) = kr;
#pragma unroll
                for (int i = 0; i < NV; ++i) *(LAS u32x4*)(lds + 2 * KBB + (cur ^ 1) * VBB + (vkey + 32 * i) * VP + vch * 16) = vr[i];
            }
            __syncthreads();
        }
        }
        const float lt = swapsum32(l);
        const float inv = 1.f / lt;
        int he = h; asm volatile("" : "+v"(he));
        int tqe = tq; asm volatile("" : "+v"(tqe));
        const float* sl2 = subln; asm volatile("" : "+s"(sl2));
#ifdef DBG
        if (NMAP == 2 && dbg) {
#pragma unroll
            for (int db = 0; db < DV / 32; ++db)
#pragma unroll
                for (int g4 = 0; g4 < 4; ++g4) {
                    const int d0 = 32 * db + 8 * g4 + 4 * he;
                    f32x4 v; v[0] = o[db][4 * g4] * inv; v[1] = o[db][4 * g4 + 1] * inv; v[2] = o[db][4 * g4 + 2] * inv; v[3] = o[db][4 * g4 + 3] * inv;
                    *(f32x4*)(dbg + ((unsigned)tqe * 1024 + mp * 512 + (ocol - 512) + d0)) = v;
                }
        }
#endif
        if (NMAP == 2 && mp == 0) {
#pragma unroll
            for (int db = 0; db < DV / 32; ++db)
#pragma unroll
                for (int c = 0; c < 2; ++c) {
                    h16x8 hv;
#pragma unroll
                    for (int jj = 0; jj < 8; ++jj) hv[jj] = (h16)(o[db][8 * c + jj] * inv);
                    stl[(db * 2 + c) * 64] = hv;
                }
        } else if (NMAP == 1) {
#pragma unroll
            for (int db = 0; db < DV / 32; ++db)
#pragma unroll
                for (int g4 = 0; g4 < 4; ++g4) {
                    const int d0 = 32 * db + 8 * g4 + 4 * he;
                    const h16x4 gt = *(const h16x4*)(Z + (zo((gcol >> 6) + (db >> 1), tqe) + (d0 & 63)));
                    u32x2 w;
                    w[0] = pk2(o[db][4 * g4 + 0] * inv * (float)gt[0], o[db][4 * g4 + 1] * inv * (float)gt[1]);
                    w[1] = pk2(o[db][4 * g4 + 2] * inv * (float)gt[2], o[db][4 * g4 + 3] * inv * (float)gt[3]);
                    *(u32x2*)(MIX + (unsigned)tqe * 1024 + ocol + d0) = w;
                }
        } else {
            float ss = 0.f;
#pragma unroll
            for (int db = 0; db < DV / 32; ++db)
#pragma unroll
                for (int c = 0; c < 2; ++c) {
                    const h16x8 hv = stl[(db * 2 + c) * 64];
#pragma unroll
                    for (int jj = 0; jj < 8; ++jj) {
                        const float a = (float)hv[jj] - lam * (o[db][8 * c + jj] * inv);
                        o[db][8 * c + jj] = a;
                        ss += a * a;
                    }
                }
            ss += __shfl_xor(ss, 32);
            const float rn = __builtin_amdgcn_rsqf(ss * (1.f / (float)DV) + EPS) * 0.8f;
#pragma unroll
            for (int db = 0; db < DV / 32; ++db)
#pragma unroll
                for (int g4 = 0; g4 < 4; ++g4) {
                    const int d0 = 32 * db + 8 * g4 + 4 * he;
                    const h16x4 gt = *(const h16x4*)(Z + (zo((gcol >> 6) + (db >> 1), tqe) + (d0 & 63)));
                    const f32x4 sg = *(const f32x4*)(sl2 + d0);
                    u32x2 w;
                    w[0] = pk2(o[db][4 * g4 + 0] * rn * sg[0] * (float)gt[0], o[db][4 * g4 + 1] * rn * sg[1] * (float)gt[1]);
                    w[1] = pk2(o[db][4 * g4 + 2] * rn * sg[2] * (float)gt[2], o[db][4 * g4 + 3] * rn * sg[3] * (float)gt[3]);
                    *(u32x2*)(MIX + (unsigned)tqe * 1024 + ocol + d0) = w;
                    if (g4 == 1 || g4 == 3) asm volatile("" : "+v"(he), "+v"(tqe) : "v"(w[1]));
                }
        }
    }
}

__device__ __forceinline__ void a2_tile(LAS const unsigned char* Kb, LAS const unsigned char* Vb, const h16x8 (&qf)[2][4], f32x16 (&o)[2][2], float (&m)[2], float (&l)[2], int lane) {
    constexpr int VP = 192;
    const int r = lane & 31, h = lane >> 5;
    f32x16 st0[2], st1[2]; float base[2];
#pragma unroll
    for (int q2 = 0; q2 < 2; ++q2) {
        base[q2] = m[q2] > -1e29f ? m[q2] : 0.f;
#pragma unroll
        for (int i = 0; i < 16; ++i) { st0[q2][i] = -base[q2]; st1[q2][i] = -base[q2]; }
    }
    LAS const unsigned char* kp = Kb + r * 144 + h * 16;
#pragma unroll
    for (int ks = 0; ks < 4; ++ks) {
        const h16x8 a0 = *(LAS const h16x8*)(kp + ks * 32);
        const h16x8 a1 = *(LAS const h16x8*)(kp + 32 * 144 + ks * 32);
#pragma unroll
        for (int q2 = 0; q2 < 2; ++q2) { st0[q2] = mfma32(a0, qf[q2][ks], st0[q2]); st1[q2] = mfma32(a1, qf[q2][ks], st1[q2]); }
    }
    h16x8 pf[2][4];
#pragma unroll
    for (int q2 = 0; q2 < 2; ++q2) {
        f32x16& s0 = st0[q2]; f32x16& s1 = st1[q2];
        float ta = max3f(s0[0], s0[1], s1[0]), tb = max3f(s0[2], s0[3], s1[1]);
        ta = max3f(ta, s1[2], s1[3]);
#pragma unroll
        for (int i = 4; i < 16; i += 4) { ta = max3f(ta, s0[i], s0[i + 1]); tb = max3f(tb, s0[i + 2], s0[i + 3]); ta = max3f(ta, s1[i], s1[i + 1]); tb = max3f(tb, s1[i + 2], s1[i + 3]); }
        const float tm = swapmax32(max2f(ta, tb));
        const float mrel = m[q2] - base[q2];
        const float mn = max2f(tm, mrel);
        m[q2] = base[q2] + mn;
        const float alpha = fexp2(mrel - mn);
        float rs = 0.f;
#pragma unroll
        for (int i = 0; i < 16; ++i) { s0[i] = fexp2(s0[i] - mn); s1[i] = fexp2(s1[i] - mn); rs += s0[i] + s1[i]; }
        l[q2] = l[q2] * alpha + rs;
        if (__builtin_amdgcn_ballot_w64(alpha != 1.f) != 0) {
#pragma unroll
            for (int db = 0; db < 2; ++db)
#pragma unroll
                for (int i = 0; i < 16; ++i) o[q2][db][i] *= alpha;
        }
#pragma unroll
        for (int j = 0; j < 8; ++j) { pf[q2][0][j] = (h16)s0[j]; pf[q2][1][j] = (h16)s0[8 + j]; pf[q2][2][j] = (h16)s1[j]; pf[q2][3][j] = (h16)s1[8 + j]; }
    }
    const int i16 = r & 15, q = i16 >> 2, p = i16 & 3, ch = r >> 4;
    LAS const unsigned char* vp = Vb + (4 * h + q) * VP + (16 * ch + 4 * p) * 2;
#pragma unroll
    for (int db = 0; db < 2; ++db)
#pragma unroll
        for (int kk = 0; kk < 4; ++kk) {
            const h16x4 lo = tr16(vp + (16 * kk) * VP + db * 64);
            const h16x4 hi = tr16(vp + (16 * kk + 8) * VP + db * 64);
            const h16x8 vf = {lo[0], lo[1], lo[2], lo[3], hi[0], hi[1], hi[2], hi[3]};
#pragma unroll
            for (int q2 = 0; q2 < 2; ++q2) o[q2][db] = mfma32(vf, pf[q2][kk], o[q2][db]);
        }
}

__device__ __forceinline__ void dense_unit_a2(const h16* __restrict__ Z, h16* __restrict__ MIX, int tseq, int S, int qb, int qslot, int kslot, int vslot, int ocol, int gslot,
                                              LAS unsigned char* lds, int wave_in) {
    constexpr int VP = 192, KBB = 64 * 144, VBB = 64 * VP;
    const int tid = wave_in * 64 + opaque_lane();
    const int lane = tid & 63, wave = tid >> 6, r = lane & 31, h = lane >> 5;
    const int tq0 = tseq + qb * 512 + wave * 64 + r;
    const int NT = S >> 6;
    const int kkey = tid >> 3, kch = tid & 7;
    h16x8 qf[2][4];
#pragma unroll
    for (int q2 = 0; q2 < 2; ++q2) {
        const unsigned qoff = zo(qslot, tq0 + 32 * q2) + 8 * h;
#pragma unroll
        for (int ks = 0; ks < 4; ++ks) qf[q2][ks] = *(const h16x8*)(Z + (qoff + 16 * ks));
    }
    f32x16 o[2][2]; float m[2], l[2];
#pragma unroll
    for (int q2 = 0; q2 < 2; ++q2) {
#pragma unroll
        for (int i = 0; i < 16; ++i) { o[q2][0][i] = 0.f; o[q2][1][i] = 0.f; }
        m[q2] = -1e30f; l[q2] = 0.f;
    }
    const unsigned koff = zo(kslot, tseq + kkey) + kch * 8;
    const unsigned voff = zo(vslot, tseq + kkey) + kch * 8;
    u32x4 kr, vr;
    kr = *(const u32x4*)(Z + koff); vr = *(const u32x4*)(Z + voff);
    __syncthreads();
    *(LAS u32x4*)(lds + kkey * 144 + kch * 16) = kr;
    *(LAS u32x4*)(lds + 2 * KBB + kkey * VP + kch * 16) = vr;
    __syncthreads();
#pragma unroll 1
    for (int j = 0; j < NT; ++j) {
        const int cur = j & 1;
        if (j + 1 < NT) { kr = *(const u32x4*)(Z + (koff + (unsigned)(64 * (j + 1)) * 64u)); vr = *(const u32x4*)(Z + (voff + (unsigned)(64 * (j + 1)) * 64u)); }
        a2_tile(lds + cur * KBB, lds + 2 * KBB + cur * VBB, qf, o, m, l, lane);
        if (j + 1 < NT) {
            *(LAS u32x4*)(lds + (cur ^ 1) * KBB + kkey * 144 + kch * 16) = kr;
            *(LAS u32x4*)(lds + 2 * KBB + (cur ^ 1) * VBB + kkey * VP + kch * 16) = vr;
        }
        __syncthreads();
    }
    int he = h, tqe = tq0; asm volatile("" : "+v"(he), "+v"(tqe));
#pragma unroll
    for (int q2 = 0; q2 < 2; ++q2) {
        const float lt = swapsum32(l[q2]);
        const float inv = 1.f / lt;
        const int tq = tqe + 32 * q2;
#pragma unroll
        for (int db = 0; db < 2; ++db)
#pragma unroll
            for (int g4 = 0; g4 < 4; ++g4) {
                const int d0 = 32 * db + 8 * g4 + 4 * he;
                const h16x4 gt = *(const h16x4*)(Z + (zo(gslot, tq) + d0));
                u32x2 w;
                w[0] = pk2(o[q2][db][4 * g4 + 0] * inv * (float)gt[0], o[q2][db][4 * g4 + 1] * inv * (float)gt[1]);
                w[1] = pk2(o[q2][db][4 * g4 + 2] * inv * (float)gt[2], o[q2][db][4 * g4 + 3] * inv * (float)gt[3]);
                *(u32x2*)(MIX + ((unsigned)tq * 1024u + ocol + d0)) = w;
            }
    }
}

template <int EXP>
__device__ __forceinline__ void dense_phase(const Params& P, LAS unsigned char* lds, int tid_in) {
    const h16* Z = (const h16*)(P.ws + WS_Z);
    h16* MIX = (h16*)(P.ws + WS_MIX);
    tid_in = __builtin_amdgcn_readfirstlane(tid_in >> 6);
    const float lam = ((const float*)(P.ws + WS_CTL))[0];
    const float* subln = P.in[13];
    for (int u0 = blockIdx.x; u0 < 2560; u0 += gridDim.x) {
        const int u = gridDim.x == 256 ? ((u0 & ~255) | ((u0 & 7) << 5) | ((u0 & 255) >> 3)) : u0;
#ifdef DENSE_ONLY_A
        if (false) {
#else
        if (u < 1280) {
#endif
            int tseq, S, hb, qb;
            if (u < 256) { const int b = u >> 6; hb = (u >> 4) & 3; qb = u & 15; tseq = TP + b * 4096; S = 4096; }
            else { const int v = u - 256; const int b = v >> 5; hb = (v >> 3) & 3; qb = v & 7; tseq = b * 2048; S = 2048; }
            dense_unit<128, 2, EXP>(Z, MIX, tseq, S, qb, 768 + hb * 128, 1280 + hb * 128, 1792 + hb * 128, 512 + hb * 128, 2304 + 512 + hb * 128, lam, subln, lds, tid_in,
#if defined(DBG) && DBG == 3
                               P.out
#else
                               nullptr
#endif
                               );
        } else {
#ifndef DENSE_ONLY_B
            int tseq, S, hq, qb;
            if (u < 1536) { const int v = u - 1280; const int b = v >> 6; hq = (v >> 3) & 7; qb = v & 7; tseq = TP + b * 4096; S = 4096; }
            else { const int v = u - 1536; const int b = v >> 5; hq = (v >> 2) & 7; qb = v & 3; tseq = b * 2048; S = 2048; }
            dense_unit_a2(Z, MIX, tseq, S, qb, hq, 8 + (hq >> 2), 10 + (hq >> 2), hq * 64, 36 + hq, lds, tid_in);
#endif
        }
    }
}

template <int NG>
__device__ __forceinline__ void banded_item(const h16* __restrict__ Z, h16* __restrict__ MIX, LAS unsigned char* ost, LAS float* mst, LAS float* lst, LAS unsigned char* vl, LAS unsigned char* kl, LAS const unsigned char* vp,
                                            int T0, int seqbase, int off0, int L, int dsh, int rc, int mblk0, int head, bool first, bool last, int lane) {
    const int r = lane & 31, h = lane >> 5;
    const int qslot = head, kslot = 16 + head, vslot = 32 + head, gslot = 48 + head;
    const int mq0 = (off0 >> dsh) + mblk0 * 32;
    int tl[NG]; h16x8 qf[NG][4]; f32x16 o[NG][2]; float m[NG], l[NG];
#pragma unroll
    for (int g = 0; g < NG; ++g) {
        tl[g] = ((mblk0 * 32 + 32 * g + r) << dsh) + rc;
        const h16* qrow = Z + (zo(qslot, T0 + tl[g]) + 8 * h);
#pragma unroll
        for (int ks = 0; ks < 4; ++ks) qf[g][ks] = *(const h16x8*)(qrow + 16 * ks);
    }
#pragma unroll
    for (int g = 0; g < NG; ++g) {
        if (first) {
#pragma unroll
            for (int i = 0; i < 16; ++i) { o[g][0][i] = 0.f; o[g][1][i] = 0.f; }
            m[g] = -1e30f; l[g] = 0.f;
        } else {
            m[g] = mst[tl[g]]; const float lt0 = lst[tl[g]]; l[g] = h == 0 ? lt0 : 0.f;
#pragma unroll
            for (int db = 0; db < 2; ++db)
#pragma unroll
                for (int g4 = 0; g4 < 4; ++g4) {
                    const h16x4 sv = *(LAS const h16x4*)(ost + tl[g] * 136 + (((8 * db + 2 * g4 + h) ^ ((tl[g] >> 5) & 15)) << 3));
#pragma unroll
                    for (int e = 0; e < 4; ++e) o[g][db][4 * g4 + e] = (float)sv[e] * lt0;
                }
        }
    }
    int kb_lo = -2, kb_hi = 1 + NG;
    while (mq0 + 32 * kb_lo < 0) ++kb_lo;
    while (mq0 + 32 * kb_hi >= L) --kb_hi;
    u32x4 krn[4], vrn[4];
#define BLOAD(kb) do { \
        _Pragma("unroll") for (int i = 0; i < 4; ++i) { const int c = lane + 64 * i; \
            const unsigned ro = (unsigned)(seqbase + ((mq0 + 32 * (kb) + (c >> 3)) << dsh) + rc) * 64u + 8 * (c & 7); \
            krn[i] = *(const u32x4*)(Z + ((unsigned)kslot * (unsigned)TT * 64u + ro)); \
            vrn[i] = *(const u32x4*)(Z + ((unsigned)vslot * (unsigned)TT * 64u + ro)); } } while (0)
    BLOAD(kb_lo);
#pragma unroll 1
    for (int kb = kb_lo; kb <= kb_hi; ++kb) {
#pragma unroll
        for (int i = 0; i < 4; ++i) { const int c = lane + 64 * i; *(LAS u32x4*)(vl + (c >> 3) * 192 + (c & 7) * 16) = vrn[i]; *(LAS u32x4*)(kl + (c >> 3) * 144 + (c & 7) * 16) = krn[i]; }
        asm volatile("s_waitcnt lgkmcnt(0)" ::: "memory");
        if (kb < kb_hi) BLOAD(kb + 1);
        h16x8 kf[4];
#pragma unroll
        for (int ks = 0; ks < 4; ++ks) kf[ks] = *(LAS const h16x8*)(kl + r * 144 + h * 16 + ks * 32);
        h16x8 pfg[NG][2];
#pragma unroll
        for (int g = 0; g < NG; ++g) {
            const int kr = kb - g;
            if (kr >= -2 && kr <= 2) {
                f32x16 st;
#pragma unroll
                for (int i = 0; i < 16; ++i) st[i] = 0.f;
#pragma unroll
                for (int ks = 0; ks < 4; ++ks) st = mfma32(kf[ks], qf[g][ks], st);
                if (kr == -2) {
#pragma unroll
                    for (int i = 0; i < 16; ++i) { const int jj = 8 * (i >> 2) + 4 * h + (i & 3); if (jj < r) st[i] = -1e30f; }
                } else if (kr == 2) {
#pragma unroll
                    for (int i = 0; i < 16; ++i) { const int jj = 8 * (i >> 2) + 4 * h + (i & 3); if (jj > r) st[i] = -1e30f; }
                }
                float tm = max3f(st[0], st[1], st[2]);
#pragma unroll
                for (int i = 3; i < 15; i += 2) tm = max3f(tm, st[i], st[i + 1]);
                tm = swapmax32(max2f(tm, st[15]));
                const float mn = max2f(m[g], tm);
                const float alpha = fexp2(m[g] - mn);
                m[g] = mn;
                float rs = 0.f;
#pragma unroll
                for (int i = 0; i < 16; ++i) { st[i] = fexp2(st[i] - mn); rs += st[i]; }
                l[g] = l[g] * alpha + rs;
#pragma unroll
                for (int j = 0; j < 8; ++j) { pfg[g][0][j] = (h16)st[j]; pfg[g][1][j] = (h16)st[8 + j]; }
                if (__builtin_amdgcn_ballot_w64(alpha != 1.f) != 0) {
#pragma unroll
                    for (int i = 0; i < 16; ++i) { o[g][0][i] *= alpha; o[g][1][i] *= alpha; }
                }
            }
        }
#pragma unroll
        for (int db = 0; db < 2; ++db)
#pragma unroll
            for (int s2 = 0; s2 < 2; ++s2) {
                const h16x4 lo = tr16(vp + (16 * s2) * 192 + db * 64);
                const h16x4 hi = tr16(vp + (16 * s2 + 8) * 192 + db * 64);
                const h16x8 vf = {lo[0], lo[1], lo[2], lo[3], hi[0], hi[1], hi[2], hi[3]};
#pragma unroll
                for (int g = 0; g < NG; ++g) {
                    const int kr = kb - g;
                    if (kr >= -2 && kr <= 2) o[g][db] = mfma32(vf, pfg[g][s2], o[g][db]);
                }
            }
        asm volatile("s_waitcnt lgkmcnt(0)" ::: "memory");
    }
#undef BLOAD
#pragma unroll
    for (int g = 0; g < NG; ++g) {
        const float lt = swapsum32(l[g]);
        const float inv = 1.f / lt;
        int tls = tl[g], hs = h; asm volatile("" : "+v"(tls), "+v"(hs));
        if (!last) {
#pragma unroll
            for (int db = 0; db < 2; ++db)
#pragma unroll
                for (int g4 = 0; g4 < 4; ++g4) {
                    u32x2 w;
                    w[0] = pk2(o[g][db][4 * g4 + 0] * inv, o[g][db][4 * g4 + 1] * inv);
                    w[1] = pk2(o[g][db][4 * g4 + 2] * inv, o[g][db][4 * g4 + 3] * inv);
                    *(LAS u32x2*)(ost + tls * 136 + (((8 * db + 2 * g4 + hs) ^ ((tls >> 5) & 15)) << 3)) = w;
                }
            if (hs == 0) { mst[tls] = m[g]; lst[tls] = lt; }
        } else {
            const int tok = T0 + tls;
#pragma unroll
            for (int db = 0; db < 2; ++db)
#pragma unroll
                for (int g4 = 0; g4 < 4; ++g4) {
                    const int d0 = 32 * db + 8 * g4 + 4 * hs;
                    const h16x4 gt = *(const h16x4*)(Z + (zo(gslot, tok) + d0));
                    u32x2 w;
                    w[0] = pk2(o[g][db][4 * g4 + 0] * inv * (float)gt[0], o[g][db][4 * g4 + 1] * inv * (float)gt[1]);
                    w[1] = pk2(o[g][db][4 * g4 + 2] * inv * (float)gt[2], o[g][db][4 * g4 + 3] * inv * (float)gt[3]);
                    *(u32x2*)(MIX + ((unsigned)tok * 1024u + head * 64 + d0)) = w;
                }
        }
    }
}

__device__ __forceinline__ void banded_phase(const Params& P, LAS unsigned char* lds, int tid_in) {
    const h16* __restrict__ Z = (const h16*)(P.ws + WS_Z);
    h16* __restrict__ MIX = (h16*)(P.ws + WS_MIX);
    int tid_ = tid_in; asm volatile("" : "+v"(tid_));
    const int tid = tid_, lane = tid & 63, wave = __builtin_amdgcn_readfirstlane(tid >> 6), r = lane & 31, h = lane >> 5;
    LAS unsigned char* ost = lds;
    LAS float* mst = (LAS float*)(lds + 69632);
    LAS float* lst = (LAS float*)(lds + 71680);
    LAS unsigned char* vl = lds + 73728 + wave * 6144;
    LAS unsigned char* kl = lds + 122880 + wave * 4608;
    const int i16 = r & 15, tq_ = i16 >> 2, tp_ = i16 & 3, tch = r >> 4;
    LAS const unsigned char* vp = vl + (4 * h + tq_) * 192 + (16 * tch + 4 * tp_) * 2;
#pragma unroll 1
    for (int u = blockIdx.x; u < 2560; u += gridDim.x) {
        const int sp = u >> 4, head = u & 15;
        const int T0 = sp * 512;
        const int S = T0 < TP ? 2048 : 4096;
        const int seqbase = T0 & ~(S - 1), off0 = T0 - seqbase;
        banded_item<2>(Z, MIX, ost, mst, lst, vl, kl, vp, T0, seqbase, off0, S, 0, 0, 2 * wave, head, true, false, lane);
        __syncthreads();
        banded_item<2>(Z, MIX, ost, mst, lst, vl, kl, vp, T0, seqbase, off0, S >> 2, 2, wave & 3, 2 * (wave >> 2), head, false, false, lane);
        __syncthreads();
#pragma unroll 1
        for (int rd = 0; rd < 2; ++rd)
            banded_item<1>(Z, MIX, ost, mst, lst, vl, kl, vp, T0, seqbase, off0, S >> 4, 4, wave + 8 * rd, 0, head, false, true, lane);
        __syncthreads();
    }
}

#ifndef MK_SP2
#define MK_SP2 true
#endif
#ifndef MK_ALIGN
#define MK_ALIGN true
#endif
template <int LO, int HI>
__global__ void __launch_bounds__(NTHREADS, 2) fwd_kernel(Params P) {
    extern __shared__ __attribute__((aligned(16))) unsigned char lds_raw[];
    LAS unsigned char* lds = (LAS unsigned char*)lds_raw;
    constexpr int lo = LO, hi = HI;
    const int wave_s = __builtin_amdgcn_readfirstlane((int)(threadIdx.x >> 6));
#define MYTID() (wave_s * 64 + opaque_lane())
    unsigned char* ws = P.ws;
#ifdef ONLY_PHASE
#define IN(k) ((k) == ONLY_PHASE && lo <= (k) && (k) < hi)
#else
#define IN(k) (lo <= (k) && (k) < hi)
#endif
#define SEAM(k) do { if (IN(k) && IN((k) + 1)) { \
        if ((k) == 0) cg::this_grid().sync(); \
        else { \
            __syncthreads(); \
            if (MYTID() == 0) { \
                unsigned* ctr = (unsigned*)(ws + WS_BAR); \
                __builtin_amdgcn_fence(__ATOMIC_RELEASE, "agent"); \
                __hip_atomic_fetch_add(ctr, 1u, __ATOMIC_RELAXED, __HIP_MEMORY_SCOPE_AGENT); \
                const unsigned target = (unsigned)(k) * gridDim.x; \
                while (__hip_atomic_load(ctr, __ATOMIC_RELAXED, __HIP_MEMORY_SCOPE_AGENT) < target) __builtin_amdgcn_s_sleep(2); \
                __builtin_amdgcn_fence(__ATOMIC_ACQUIRE, "agent"); \
            } \
            __syncthreads(); \
        } } } while (0)
    if (IN(0)) p0_phase(P, lds, MYTID());
    SEAM(0);
    if (IN(1)) {
        pg8::Gemm g{(const pg8::bf16_t*)(ws + WS_XH), (const pg8::bf16_t*)(ws + WS_WIN0), TT, N0, DM};
        pg8::StaticOrder S; S.init(TT, N0, (int)gridDim.x, (int)blockIdx.x);
        EpiIn E{(h16*)(ws + WS_Z), N0, 0, (const float*)(ws + WS_SSQ0), P.in[5], P.in[6], P.in[7], P.in[8]};
        pg8::gemm_phase<EpiIn, pg8::StaticOrder, MK_ALIGN, MK_SP2>(lds, g, S, E, MYTID());
#if defined(MK_DUP_PHASE) && MK_DUP_PHASE == 1
        __syncthreads();
        pg8::gemm_phase<EpiIn, pg8::StaticOrder, MK_ALIGN, MK_SP2>(lds, g, S, E, MYTID());
#endif
    }
    SEAM(1);
#ifdef MK_EXP
    if (IN(2)) { dense_phase<MK_EXP>(P, lds, MYTID()); __syncthreads(); }
#endif
    if (IN(2)) dense_phase<0>(P, lds, MYTID());
#if defined(MK_DUP_PHASE) && MK_DUP_PHASE == 2
    if (IN(2)) { __syncthreads(); dense_phase<0>(P, lds, MYTID()); }
#endif
    SEAM(2);
    if (IN(3)) {
        pg8::Gemm g{(const pg8::bf16_t*)(ws + WS_MIX), (const pg8::bf16_t*)(ws + WS_WOUT0), TT, DM, DM};
        pg8::StaticOrder S; S.init(TT, DM, (int)gridDim.x, (int)blockIdx.x);
        EpiOut0 E{P.in[0], P.in[1], (h16*)(ws + WS_XH), (float*)(ws + WS_SSQ1)};
        pg8::gemm_phase<EpiOut0, pg8::StaticOrder, MK_ALIGN, MK_SP2>(lds, g, S, E, MYTID());
    }
    SEAM(3);
    if (IN(4)) {
        pg8::Gemm g{(const pg8::bf16_t*)(ws + WS_XH), (const pg8::bf16_t*)(ws + WS_WIN1), TT, N1, DM};
        pg8::StaticOrder S; S.init(TT, N1, (int)gridDim.x, (int)blockIdx.x);
        EpiIn E{(h16*)(ws + WS_Z), N1, 1, (const float*)(ws + WS_SSQ1), P.in[17], P.in[18], P.in[17], P.in[18]};
        pg8::gemm_phase<EpiIn, pg8::StaticOrder, MK_ALIGN, MK_SP2>(lds, g, S, E, MYTID());
    }
    SEAM(4);
    if (IN(5)) banded_phase(P, lds, MYTID());
#if defined(MK_DUP_PHASE) && MK_DUP_PHASE == 5
    if (IN(5)) { __syncthreads(); banded_phase(P, lds, MYTID()); }
#endif
    SEAM(5);
    if (IN(6)) {
        pg8::Gemm g{(const pg8::bf16_t*)(ws + WS_MIX), (const pg8::bf16_t*)(ws + WS_WOUT1), TT, DM, DM};
        pg8::StaticOrder S; S.init(TT, DM, (int)gridDim.x, (int)blockIdx.x);
        EpiOut1 E{(const h16*)(ws + WS_XH), P.out};
        pg8::gemm_phase<EpiOut1, pg8::StaticOrder, MK_ALIGN, MK_SP2>(lds, g, S, E, MYTID());
    }
#undef IN
#undef SEAM
}

#ifndef MK_LAUNCHES
#define MK_LAUNCHES 1
#endif
template <int LO, int HI>
static void launch_range(const Params& p0, int grid, hipStream_t stream, bool coop) {
    Params p = p0; p.ph_lo = LO; p.ph_hi = HI;
    if (coop) {
        void* args[] = {&p};
        hipError_t e = hipLaunchCooperativeKernel((const void*)fwd_kernel<LO, HI>, dim3(grid), dim3(NTHREADS), args, LDS_BYTES, stream);
        if (e != hipSuccess) fprintf(stderr, "cooperative launch failed: %s (grid %d)\n", hipGetErrorString(e), grid);
    } else {
        hipLaunchKernelGGL((fwd_kernel<LO, HI>), dim3(grid), dim3(NTHREADS), LDS_BYTES, stream, p);
    }
}
template <int LO, int HI>
static bool prep_kernel(int& per_cu) {
    if (hipFuncSetAttribute((const void*)fwd_kernel<LO, HI>, hipFuncAttributeMaxDynamicSharedMemorySize, LDS_BYTES) != hipSuccess) { fprintf(stderr, "kernel_launch: hipFuncSetAttribute failed\n"); return false; }
    int pc = 0;
    if (hipOccupancyMaxActiveBlocksPerMultiprocessor(&pc, (const void*)fwd_kernel<LO, HI>, NTHREADS, LDS_BYTES) != hipSuccess || pc < 1) { fprintf(stderr, "kernel_launch: occupancy query gave %d\n", pc); pc = 1; (void)hipGetLastError(); }
    if (pc < per_cu) per_cu = pc;
    return true;
}
extern "C" void kernel_launch(void* const* d_in, const int* in_sizes, int n_in, void* d_out, int out_size, void* d_ws, size_t ws_size, hipStream_t stream) {
    static int grid = 0;
    if (grid == 0) {
        int dev = 0, cus = 0, per_cu = 64;
        if (hipGetDevice(&dev) != hipSuccess || hipDeviceGetAttribute(&cus, hipDeviceAttributeMultiprocessorCount, dev) != hipSuccess) { fprintf(stderr, "kernel_launch: device query failed\n"); grid = -1; return; }
        bool ok = true;
#if MK_LAUNCHES == 1
        ok = prep_kernel<0, 7>(per_cu);
#else
        ok = prep_kernel<0, 1>(per_cu) && prep_kernel<1, 2>(per_cu) && prep_kernel<2, 3>(per_cu) && prep_kernel<3, 4>(per_cu) && prep_kernel<4, 5>(per_cu) && prep_kernel<5, 6>(per_cu) && prep_kernel<6, 7>(per_cu);
#endif
        if (!ok) { grid = -1; return; }
        grid = cus * per_cu;
        if (ws_size < WS_END) fprintf(stderr, "kernel_launch: workspace too small: %zu < %zu\n", ws_size, (size_t)WS_END);
    }
    if (grid < 0) return;
    Params p{};
    for (int i = 0; i < 19; ++i) p.in[i] = (const float*)d_in[i];
    p.out = (float*)d_out; p.ws = (unsigned char*)d_ws;
    for (int j = 0; j < 8; ++j) p.frq[j] = pow(500000.0, -(double)(2 * j) / 16.0);
    for (int j = 0; j < 16; ++j) p.frq[8 + j] = pow(10000.0, -(double)(2 * j) / 32.0);
#if MK_LAUNCHES == 1
    (void)hipMemsetAsync((unsigned char*)d_ws + WS_BAR, 0, 256, stream);
    launch_range<0, 7>(p, grid, stream, true);
#else
    launch_range<0, 1>(p, grid, stream, false); launch_range<1, 2>(p, grid, stream, false); launch_range<2, 3>(p, grid, stream, false); launch_range<3, 4>(p, grid, stream, false);
    launch_range<4, 5>(p, grid, stream, false); launch_range<5, 6>(p, grid, stream, false); launch_range<6, 7>(p, grid, stream, false);
#endif
}
```

```cpp
#include <hip/hip_runtime.h>
#include <hip/hip_cooperative_groups.h>
#include <cstdio>
#include <cstdint>
#include <cmath>
namespace cg = cooperative_groups;
namespace pg8 {
#define PG8_LAS __attribute__((address_space(3)))
typedef unsigned short bf16_t;
typedef _Float16 bf16x8 __attribute__((ext_vector_type(8)));
typedef float f32x4 __attribute__((ext_vector_type(4)));
typedef unsigned u32x4 __attribute__((ext_vector_type(4)));
constexpr int BM = 256, BK = 64, HALF = 128, HTB = HALF * BK * 2  , STAGE_BYTES = 8 * HTB, NXCD = 8, WGM = 8;

__host__ __device__ __forceinline__ int lds_byte(int r, int c) { const int st = (r >> 4) * 2 + (c >> 5), rr = r & 15, cc = c & 31, ob = rr * 64 + cc * 2; return st * 1024 + (ob ^ (((ob >> 9) & 1) << 5)); }
__host__ __device__ __forceinline__ void stage_rc(int b, int& R, int& C) { const int st = b / 1024, sb = b % 1024, swz = sb ^ (((sb >> 9) & 1) << 5); R = (st >> 1) * 16 + swz / 64; C = (st & 1) * 32 + (swz % 64) / 2; }
__host__ __device__ __forceinline__ int perm32(int rho) { const int n = rho >> 4, i = rho & 15; return 8 * (i >> 2) + 4 * n + (i & 3); }

struct Unit { int pm, pn; };
struct Gemm { const bf16_t* A; const bf16_t* Bt; int M, N, K; };

struct StaticOrder {
    int nM, nN, nwg, G, c;
    __host__ __device__ void init(int M, int N, int G_, int c_) { nM = M / BM; nN = N / BM; nwg = nM * nN; G = G_; c = c_; }
    __host__ __device__ bool next(int i, Unit& u) const {
        const long L = (long)i * G + c; if (L >= nwg) return false;
        int wgid = (int)L; { const int q = nwg / NXCD, r = nwg % NXCD, xcd = wgid % NXCD, off = wgid / NXCD; wgid = (xcd < r ? xcd * (q + 1) : r * (q + 1) + (xcd - r) * q) + off; }
        const int nig = WGM * nN, gid = wgid / nig, fm = gid * WGM, gsz = (nM - fm) < WGM ? (nM - fm) : WGM;
        u.pm = fm + ((wgid % nig) % gsz); u.pn = (wgid % nig) / gsz; return true;
    }
    __device__ __forceinline__ void a_ready(const Unit&) const {}
    __device__ __forceinline__ void done(const Unit&) const {}
};
template <class Epi, class Sched, bool ALIGN_EPI = false, bool SP2 = false>
__device__ __forceinline__ void gemm_phase(PG8_LAS unsigned char* lds, const Gemm g, const Sched& S, const Epi& E, int tid_in) {
    int tid_ = tid_in; asm volatile("" : "+v"(tid_));
    const int tid = tid_, wid = __builtin_amdgcn_readfirstlane(tid >> 6), lane = tid & 63, wr = wid >> 2, wc = wid & 3, fr = lane & 15, fq = lane >> 4;
    const int K = g.K, nt = K / BK;
    unsigned voffA[2], voffB[2];
#pragma unroll
    for (int i = 0; i < 2; ++i) { int R, C; stage_rc(tid * 16 + i * 8192, R, C); const int Rb = Epi::PERM ? ((R & ~31) + perm32(R & 31)) : R;
        voffA[i] = (unsigned)(R * K + C) * 2u; voffB[i] = (unsigned)(Rb * K + C) * 2u; }
    const size_t kstep = (size_t)(BK * 2);
    const size_t hstep = (size_t)HALF * K * 2;
    const size_t tstep = 2 * hstep;
    const unsigned ldsw = (unsigned)wid * 1024u;
    const int aoff = lds_byte(wr * 64 + fr, fq * 8), boff = lds_byte(wc * 32 + fr, fq * 8);
#define PG8_SA(b, h) (((b) * 2 + (h)) * HTB)
#define PG8_SB(b, h) ((4 + (b) * 2 + (h)) * HTB)
#define PG8_STAGE(bufoff, gbase, voff) do { _Pragma("unroll") for (int _i = 0; _i < 2; ++_i) \
        __builtin_amdgcn_global_load_lds((const unsigned*)((const char*)(gbase) + (voff)[_i]), (PG8_LAS unsigned*)(lds + (bufoff) + ldsw + _i * 8192), 16, 0, 0); } while (0)
#define PG8_LDA(dst, b, h) do { _Pragma("unroll") for (int m = 0; m < 4; ++m) _Pragma("unroll") for (int k = 0; k < 2; ++k) dst[m][k] = *(const PG8_LAS bf16x8*)(lds + PG8_SA(b, h) + aoff + m * 2048 + k * 1024); } while (0)
#define PG8_LDB(dst, b, h) do { _Pragma("unroll") for (int n = 0; n < 2; ++n) _Pragma("unroll") for (int k = 0; k < 2; ++k) dst[n][k] = *(const PG8_LAS bf16x8*)(lds + PG8_SB(b, h) + boff + n * 2048 + k * 1024); } while (0)
#define PG8_MMA(ai, bj, At, Bt) do { __builtin_amdgcn_s_setprio(1); _Pragma("unroll") for (int m = 0; m < 4; ++m) _Pragma("unroll") for (int n = 0; n < 2; ++n) _Pragma("unroll") for (int k = 0; k < 2; ++k) \
        acc[ai][bj][m][n] = __builtin_amdgcn_mfma_f32_16x16x32_f16(Bt[n][k], At[m][k], acc[ai][bj][m][n], 0, 0, 0); __builtin_amdgcn_s_setprio(0); } while (0)
#define PG8_WAIT_V(n) asm volatile("s_waitcnt vmcnt(" #n ")" ::: "memory")
#define PG8_WAIT_L(n) asm volatile("s_waitcnt lgkmcnt(" #n ")" ::: "memory")
#define PG8_BAR __builtin_amdgcn_s_barrier()
#define PG8_SCHED __builtin_amdgcn_sched_barrier(0)
    Unit cur, nxt; int ui = 0;
    if (!S.next(0, cur)) return;
    f32x4 acc[2][2][4][2];
#pragma unroll
    for (int a = 0; a < 2; ++a)
#pragma unroll
        for (int b = 0; b < 2; ++b)
#pragma unroll
            for (int m = 0; m < 4; ++m)
#pragma unroll
                for (int n = 0; n < 2; ++n) acc[a][b][m][n] = (f32x4){0.f, 0.f, 0.f, 0.f};
    bf16x8 At[4][2], B0[2][2], B1[2][2];
    const char* cA = (const char*)g.A + (size_t)cur.pm * tstep; const char* cB = (const char*)g.Bt + (size_t)cur.pn * tstep;
    S.a_ready(cur);
    if constexpr (SP2) {
        PG8_STAGE(PG8_SB(0, 0), cB, voffB); PG8_STAGE(PG8_SB(0, 1), cB + hstep, voffB); PG8_STAGE(PG8_SA(0, 0), cA, voffA); PG8_STAGE(PG8_SA(0, 1), cA + hstep, voffA);
        if (wr == 1) PG8_BAR;
        PG8_WAIT_V(2); PG8_BAR;
        PG8_STAGE(PG8_SB(1, 0), cB + kstep, voffB); PG8_STAGE(PG8_SA(1, 0), cA + kstep, voffA); PG8_STAGE(PG8_SB(1, 1), cB + hstep + kstep, voffB);
        PG8_WAIT_V(6); PG8_BAR;
    } else {
        PG8_STAGE(PG8_SB(0, 0), cB, voffB); PG8_STAGE(PG8_SA(0, 0), cA, voffA); PG8_STAGE(PG8_SB(0, 1), cB + hstep, voffB); PG8_STAGE(PG8_SA(0, 1), cA + hstep, voffA);
        if (wr == 1) PG8_BAR;
        PG8_WAIT_V(4); PG8_BAR;
        PG8_STAGE(PG8_SB(1, 0), cB + kstep, voffB); PG8_STAGE(PG8_SA(1, 0), cA + kstep, voffA); PG8_STAGE(PG8_SB(1, 1), cB + hstep + kstep, voffB);
        PG8_WAIT_V(6); PG8_BAR;
    }
    for (;;) {
        const bool has_next = S.next(ui + 1, nxt);
        const char* nA = has_next ? (const char*)g.A + (size_t)nxt.pm * tstep : cA; const char* nB = has_next ? (const char*)g.Bt + (size_t)nxt.pn * tstep : cB;
        for (int t = 0; t < nt; t += 2) {
            const bool last = (t == nt - 2);
            const char* a1 = cA + (size_t)(t + 1) * kstep;
            const char* a2 = last ? nA : cA + (size_t)(t + 2) * kstep; const char* b2 = last ? nB : cB + (size_t)(t + 2) * kstep;
            const char* a3 = a2 + kstep; const char* b3 = b2 + kstep;
            if (last && has_next) S.a_ready(nxt);
            if constexpr (SP2) {
            PG8_LDB(B0, 0, 0); PG8_LDB(B1, 0, 1); PG8_SCHED; PG8_LDA(At, 0, 0); PG8_STAGE(PG8_SA(1, 1), a1 + hstep, voffA);
            PG8_WAIT_V(8); PG8_WAIT_L(0); PG8_BAR; PG8_MMA(0, 0, At, B0); PG8_MMA(0, 1, At, B1); PG8_BAR; PG8_SCHED;
            PG8_LDA(At, 0, 1); PG8_STAGE(PG8_SB(0, 0), b2, voffB); PG8_STAGE(PG8_SB(0, 1), b2 + hstep, voffB); PG8_STAGE(PG8_SA(0, 0), a2, voffA);
            PG8_WAIT_V(8); PG8_WAIT_L(0); PG8_BAR; PG8_MMA(1, 0, At, B0); PG8_MMA(1, 1, At, B1); PG8_BAR; PG8_SCHED;
            PG8_LDB(B0, 1, 0); PG8_LDB(B1, 1, 1); PG8_SCHED; PG8_LDA(At, 1, 0); PG8_STAGE(PG8_SA(0, 1), a2 + hstep, voffA);
            PG8_WAIT_V(8); PG8_WAIT_L(0); PG8_BAR; PG8_MMA(0, 0, At, B0); PG8_MMA(0, 1, At, B1); PG8_BAR; PG8_SCHED;
            PG8_LDA(At, 1, 1); PG8_STAGE(PG8_SB(1, 0), b3, voffB); PG8_STAGE(PG8_SB(1, 1), b3 + hstep, voffB); PG8_STAGE(PG8_SA(1, 0), a3, voffA);
            PG8_WAIT_V(8); PG8_WAIT_L(0); PG8_BAR; PG8_MMA(1, 0, At, B0); PG8_MMA(1, 1, At, B1); PG8_BAR; PG8_SCHED;
            } else {
            PG8_LDB(B0, 0, 0); PG8_SCHED; PG8_LDA(At, 0, 0); PG8_STAGE(PG8_SA(1, 1), a1 + hstep, voffA);
            PG8_WAIT_L(8); PG8_BAR; PG8_WAIT_L(0); PG8_MMA(0, 0, At, B0); PG8_BAR; PG8_SCHED;
            PG8_LDB(B1, 0, 1); PG8_STAGE(PG8_SB(0, 0), b2, voffB);
            PG8_BAR; PG8_WAIT_L(0); PG8_MMA(0, 1, At, B1); PG8_BAR;
            PG8_LDA(At, 0, 1); PG8_STAGE(PG8_SA(0, 0), a2, voffA);
            PG8_BAR; PG8_WAIT_L(0); PG8_MMA(1, 0, At, B0); PG8_BAR; PG8_SCHED;
            PG8_STAGE(PG8_SB(0, 1), b2 + hstep, voffB);
            PG8_WAIT_V(6); PG8_BAR; PG8_MMA(1, 1, At, B1); PG8_BAR;
            PG8_LDB(B0, 1, 0); PG8_SCHED; PG8_LDA(At, 1, 0); PG8_STAGE(PG8_SA(0, 1), a2 + hstep, voffA);
            PG8_WAIT_L(8); PG8_BAR; PG8_WAIT_L(0); PG8_MMA(0, 0, At, B0); PG8_BAR; PG8_SCHED;
            PG8_LDB(B1, 1, 1); PG8_STAGE(PG8_SB(1, 0), b3, voffB);
            PG8_BAR; PG8_WAIT_L(0); PG8_MMA(0, 1, At, B1); PG8_BAR;
            PG8_LDA(At, 1, 1); PG8_STAGE(PG8_SA(1, 0), a3, voffA);
            PG8_BAR; PG8_WAIT_L(0); PG8_MMA(1, 0, At, B0); PG8_BAR; PG8_SCHED;
            PG8_STAGE(PG8_SB(1, 1), b3 + hstep, voffB);
            PG8_WAIT_V(6); PG8_BAR; PG8_MMA(1, 1, At, B1); PG8_BAR;
            }
        }
        if constexpr (ALIGN_EPI) { if (wr == 0) PG8_BAR; }
        if constexpr (!Epi::AFTER_DRAIN) { E(acc, cur, wr, wc, fr, fq); S.done(cur); }
        if (!has_next) break;
#pragma unroll
        for (int a = 0; a < 2; ++a)
#pragma unroll
            for (int b = 0; b < 2; ++b)
#pragma unroll
                for (int m = 0; m < 4; ++m)
#pragma unroll
                    for (int n = 0; n < 2; ++n) acc[a][b][m][n] = (f32x4){0.f, 0.f, 0.f, 0.f};
        cur = nxt; cA = nA; cB = nB; ++ui;
        if constexpr (ALIGN_EPI) { if (wr == 1) PG8_BAR; }
    }
    PG8_WAIT_V(0);
    if constexpr (!ALIGN_EPI) { if (wr == 0) PG8_BAR; }
    PG8_BAR;
    if constexpr (Epi::AFTER_DRAIN) { E.fused(acc, cur, wr, wc, fr, fq, lds, wid, lane); S.done(cur); }
#undef PG8_SA
#undef PG8_SB
#undef PG8_STAGE
#undef PG8_LDA
#undef PG8_LDB
#undef PG8_MMA
#undef PG8_WAIT_V
#undef PG8_WAIT_L
#undef PG8_BAR
#undef PG8_SCHED
}
}

#define LAS __attribute__((address_space(3)))
typedef _Float16 h16;
typedef h16 h16x2 __attribute__((ext_vector_type(2)));
typedef h16 h16x4 __attribute__((ext_vector_type(4)));
typedef h16 h16x8 __attribute__((ext_vector_type(8)));
typedef float f32x4 __attribute__((ext_vector_type(4)));
typedef float f32x16 __attribute__((ext_vector_type(16)));
typedef unsigned u32x4 __attribute__((ext_vector_type(4)));
typedef unsigned u32x2 __attribute__((ext_vector_type(2)));

constexpr int TP = 65536, TS = 16384, TT = TP + TS, DM = 1024, N0 = 3328, N1 = 4096;
constexpr float EPS = 1e-6f;
constexpr float QSCALE = 0.125f * 1.4426950408889634f;
constexpr size_t MiB = 1u << 20;
constexpr size_t WS_CTL = 0, WS_BAR = 4096;
constexpr size_t WS_TAXC = 1 * MiB, WS_TAXS = 1 * MiB + 8192, WS_TPRC = 1 * MiB + 65536, WS_TPRS = 1 * MiB + 65536 + 131072;
constexpr size_t WS_SSQ0 = 2 * MiB, WS_SSQ1 = 2 * MiB + 512 * 1024;
constexpr size_t WS_WIN0 = 3 * MiB, WS_WOUT0 = 10 * MiB, WS_WIN1 = 12 * MiB, WS_WOUT1 = 20 * MiB;
constexpr size_t WS_XH = 24 * MiB, WS_MIX = 184 * MiB, WS_Z = 344 * MiB, WS_STASH = 984 * MiB, WS_END = 1008 * MiB;
constexpr int LDS_BYTES = 163840;
constexpr int NTHREADS = 512;

struct Params {
    const float* in[19];
    float* out;
    unsigned char* ws;
    int ph_lo, ph_hi;
    double frq[24];
};

__device__ __forceinline__ float wave_sum(float v) {
#pragma unroll
    for (int o = 32; o; o >>= 1) v += __shfl_xor(v, o);
    return v;
}
__device__ __forceinline__ int opaque_lane() { int l; asm volatile("v_mbcnt_lo_u32_b32 %0, -1, 0\n\tv_mbcnt_hi_u32_b32 %0, -1, %0" : "=v"(l)); return l; }
__device__ __forceinline__ float max3f(float a, float b, float c) { float r; asm("v_max3_f32 %0, %1, %2, %3" : "=v"(r) : "v"(a), "v"(b), "v"(c)); return r; }
__device__ __forceinline__ float max2f(float a, float b) { float r; asm("v_max_f32_e32 %0, %1, %2" : "=v"(r) : "v"(a), "v"(b)); return r; }
__device__ __forceinline__ float swapmax32(float v) {
    auto rr = __builtin_amdgcn_permlane32_swap(__float_as_uint(v), __float_as_uint(v), false, false);
    return max2f(__uint_as_float(rr[0]), __uint_as_float(rr[1]));
}
__device__ __forceinline__ float swapsum32(float v) {
    auto rr = __builtin_amdgcn_permlane32_swap(__float_as_uint(v), __float_as_uint(v), false, false);
    return __uint_as_float(rr[0]) + __uint_as_float(rr[1]);
}
__device__ __forceinline__ unsigned zo(int slot, int row) { return ((unsigned)slot * (unsigned)TT + (unsigned)row) * 64u; }
__device__ __forceinline__ float fexp2(float x) { return __builtin_amdgcn_exp2f(x); }
__device__ __forceinline__ unsigned pk2(float a, float b) { h16x2 v = {(h16)a, (h16)b}; return __builtin_bit_cast(unsigned, v); }
__device__ __forceinline__ h16x4 tr16(LAS const unsigned char* p) {
    typedef short v4i16_t __attribute__((ext_vector_type(4)));
    return __builtin_bit_cast(h16x4, __builtin_amdgcn_ds_read_tr16_b64_v4i16((LAS v4i16_t*)p));
}
__device__ __forceinline__ f32x16 mfma32(h16x8 a, h16x8 b, f32x16 c) { return __builtin_amdgcn_mfma_f32_32x32x16_f16(a, b, c, 0, 0, 0); }

__device__ __forceinline__ void p0_phase(const Params& P, LAS unsigned char* lds, int tid_in) {
    int tid_ = tid_in; asm volatile("" : "+v"(tid_));
    const int tid = tid_, lane = tid & 63, wave = tid >> 6, bid = blockIdx.x, nb = gridDim.x;
    unsigned char* ws = P.ws;
    LAS h16* ts = (LAS h16*)lds;
    for (int tile = bid; tile < 2368; tile += nb) {
        const int ntile = tile >> 4, kt = tile & 15;
        const float* w; const float* g; h16* wt; int N, nt, perm;
        if (ntile < 52)       { w = P.in[3];  g = P.in[2];  wt = (h16*)(ws + WS_WIN0);  N = N0;   nt = ntile;       perm = 1; }
        else if (ntile < 68)  { w = P.in[4];  g = nullptr;  wt = (h16*)(ws + WS_WOUT0); N = 1024; nt = ntile - 52;  perm = 0; }
        else if (ntile < 132) { w = P.in[15]; g = P.in[14]; wt = (h16*)(ws + WS_WIN1);  N = N1;   nt = ntile - 68;  perm = 1; }
        else                  { w = P.in[16]; g = nullptr;  wt = (h16*)(ws + WS_WOUT1); N = 1024; nt = ntile - 132; perm = 0; }
        const int k0 = kt * 64, n0 = nt * 64;
#pragma unroll
        for (int i = 0; i < 8; ++i) {
            const int kk = wave + 8 * i;
            float v = w[(size_t)(k0 + kk) * N + n0 + lane];
            if (g) v *= g[k0 + kk];
            ts[kk * 66 + lane] = (h16)v;
        }
        __syncthreads();
#pragma unroll
        for (int i = 0; i < 8; ++i) {
            const int nn = wave + 8 * i;
            const int c = n0 + nn;
            int pr = c;
            if (perm) { const int t256 = c >> 8, lc = c & 255, hh = lc >> 6, d = lc & 63; pr = (t256 << 8) + 128 * (d >> 5) + 32 * hh + (d & 31); }
            wt[(size_t)pr * 1024 + k0 + lane] = ts[lane * 66 + nn];
        }
        __syncthreads();
    }
    h16* XH = (h16*)(ws + WS_XH);
    float* ssq0 = (float*)(ws + WS_SSQ0);
    float* ssq1 = (float*)(ws + WS_SSQ1);
    for (int row0 = bid * 8 + wave; row0 < TT; row0 += nb * 32) {
        f32x4 v[4][4];
#pragma unroll
        for (int t = 0; t < 4; ++t) {
            const int row = row0 + t * nb * 8;
            if (row < TT) {
                const float* src = row < TP ? P.in[0] + (size_t)row * 1024 : P.in[1] + (size_t)(row - TP) * 1024;
#pragma unroll
                for (int i = 0; i < 4; ++i) v[t][i] = __builtin_nontemporal_load((const f32x4*)(src + i * 256 + lane * 4));
            }
        }
#pragma unroll
        for (int t = 0; t < 4; ++t) {
            const int row = row0 + t * nb * 8;
            if (row < TT) {
                h16* dst = XH + (size_t)row * 1024;
                float ss = 0.f;
#pragma unroll
                for (int i = 0; i < 4; ++i) {
                    ss += v[t][i][0] * v[t][i][0] + v[t][i][1] * v[t][i][1] + v[t][i][2] * v[t][i][2] + v[t][i][3] * v[t][i][3];
                    u32x2 pk; pk[0] = pk2(v[t][i][0], v[t][i][1]); pk[1] = pk2(v[t][i][2], v[t][i][3]);
                    *(u32x2*)(dst + i * 256 + lane * 4) = pk;
                }
                ss = wave_sum(ss);
                if (lane == 0) ssq0[row] = ss;
            }
        }
    }
    const int gtid = bid * NTHREADS + tid, gn = nb * NTHREADS;
    for (int i = gtid; i < TT; i += gn) ssq1[i] = 0.f;
    if (bid == 0 && wave == 0) {
        float a = P.in[9][lane] * P.in[10][lane], b = P.in[11][lane] * P.in[12][lane];
        a = wave_sum(a); b = wave_sum(b);
        if (lane == 0) ((float*)(ws + WS_CTL))[0] = __expf(a) - __expf(b) + 0.2f;
    }
}

__device__ __forceinline__ float partner16(float x) {
    auto r = __builtin_amdgcn_permlane16_swap(__float_as_uint(x), __float_as_uint(x), false, false);
    return __uint_as_float(r[0] == __float_as_uint(x) ? r[1] : r[0]);
}
__device__ __forceinline__ float partner32(float x) {
    auto r = __builtin_amdgcn_permlane32_swap(__float_as_uint(x), __float_as_uint(x), false, false);
    return __uint_as_float(r[0] == __float_as_uint(x) ? r[1] : r[0]);
}
__device__ __forceinline__ float sum16(float x) { auto r = __builtin_amdgcn_permlane16_swap(__float_as_uint(x), __float_as_uint(x), false, false); return __uint_as_float(r[0]) + __uint_as_float(r[1]); }
__device__ __forceinline__ float sum32(float x) { auto r = __builtin_amdgcn_permlane32_swap(__float_as_uint(x), __float_as_uint(x), false, false); return __uint_as_float(r[0]) + __uint_as_float(r[1]); }

struct EpiIn {
    static constexpr bool PERM = true, AFTER_DRAIN = false;
    h16* Z; int ldz; int layer; const float* ssq;
    const float* g0; const float* g1; const float* g2; const float* g3;
    __device__ __forceinline__ void operator()(const pg8::f32x4 (&acc)[2][2][4][2], const pg8::Unit& u, int wr, int wc, int fr, int fq) const {
        const int gh = u.pn * 4 + wc;
        int type; const float* gain = g0; float qs = 1.f;
        if (layer == 0) {
            if (gh < 8) { type = 2; gain = g0; qs = QSCALE; }
            else if (gh < 10) { type = 2; gain = g1; }
            else if (gh < 12) { type = 0; }
            else if (gh < 20) { type = 1; gain = g2; qs = QSCALE; }
            else if (gh < 28) { type = 1; gain = g3; }
            else if (gh < 36) { type = 0; }
            else { type = 3; }
        } else {
            if (gh < 16) { type = 1; gain = g2; qs = QSCALE; }
            else if (gh < 32) { type = 1; gain = g3; }
            else if (gh < 48) { type = 0; }
            else { type = 3; }
        }
        type = __builtin_amdgcn_readfirstlane(type);
        constexpr float PRF[8] = {1.591549431e-01f, 3.086376340e-02f, 5.985185713e-03f, 1.160663641e-03f, 2.250790790e-04f, 4.364795279e-05f, 8.464330808e-06f, 1.641426263e-06f};
        constexpr float AXF[16] = {1.591549431e-01f, 8.949940161e-02f, 5.032921210e-02f, 2.830219583e-02f, 1.591549431e-02f, 8.949940161e-03f, 5.032921210e-03f, 2.830219583e-03f,
                                   1.591549431e-03f, 8.949940161e-04f, 5.032921210e-04f, 2.830219583e-04f, 1.591549431e-04f, 8.949940161e-05f, 5.032921210e-05f, 2.830219583e-05f};
        float gv[2][8], frev[8];
#pragma unroll
        for (int e = 0; e < 8; ++e) frev[e] = type == 1 ? PRF[e] : ((fq & 1) ? AXF[8 + e] : AXF[e]);
#pragma unroll
        for (int bj = 0; bj < 2; ++bj)
#pragma unroll
            for (int e = 0; e < 8; ++e) gv[bj][e] = (type == 1 || type == 2) ? gain[32 * bj + 8 * fq + e] * qs : 1.f;
        h16* zcol = Z + 8 * fq;
        float rsv[2][4];
#pragma unroll
        for (int ai = 0; ai < 2; ++ai)
#pragma unroll
            for (int m = 0; m < 4; ++m) rsv[ai][m] = ssq[u.pm * 256 + ai * 128 + wr * 64 + m * 16 + fr];
#pragma unroll
        for (int ai = 0; ai < 2; ++ai)
#pragma unroll
            for (int m = 0; m < 4; ++m) {
                const int row = u.pm * 256 + ai * 128 + wr * 64 + m * 16 + fr;
                const float rs = __builtin_amdgcn_rsqf(rsv[ai][m] * (1.f / 1024.f) + EPS);
                float v[2][8];
#pragma unroll
                for (int bj = 0; bj < 2; ++bj)
#pragma unroll
                    for (int n = 0; n < 2; ++n)
#pragma unroll
                        for (int e = 0; e < 4; ++e) v[bj][4 * n + e] = acc[ai][bj][m][n][e] * rs;
                if (type == 1 || type == 2) {
                    float ss = 0.f;
#pragma unroll
                    for (int bj = 0; bj < 2; ++bj)
#pragma unroll
                        for (int e = 0; e < 8; ++e) ss += v[bj][e] * v[bj][e];
                    ss = sum32(sum16(ss));
                    const float rn = __builtin_amdgcn_rsqf(ss * (1.f / 64.f) + EPS);
#pragma unroll
                    for (int bj = 0; bj < 2; ++bj)
#pragma unroll
                        for (int e = 0; e < 8; ++e) v[bj][e] *= rn * gv[bj][e];
                    const int s = row < TP ? (row & 2047) : (row & 4095);
                    if (type == 1) {
                        const float pos = (float)s;
                        const float sg = fq == 0 ? -1.f : 1.f;
#pragma unroll
                        for (int e = 0; e < 8; ++e) {
                            const float pr = partner16(v[0][e]);
                            const float ang = __builtin_amdgcn_fractf(pos * frev[e]);
                            const float cs = __builtin_amdgcn_cosf(ang), sn = __builtin_amdgcn_sinf(ang);
                            const float rv = v[0][e] * cs + sg * pr * sn;
                            v[0][e] = fq < 2 ? rv : v[0][e];
                        }
                    } else {
                        const float sg = fq < 2 ? -1.f : 1.f;
#pragma unroll
                        for (int bj = 0; bj < 2; ++bj) {
                            const float pos = (float)(bj == 0 ? (s >> 6) : (s & 63));
#pragma unroll
                            for (int e = 0; e < 8; ++e) {
                                const float pr = partner32(v[bj][e]);
                                const float ang = __builtin_amdgcn_fractf(pos * frev[e]);
                                const float cs = __builtin_amdgcn_cosf(ang), sn = __builtin_amdgcn_sinf(ang);
                                v[bj][e] = v[bj][e] * cs + sg * pr * sn;
                            }
                        }
                    }
                } else if (type == 3) {
#pragma unroll
                    for (int bj = 0; bj < 2; ++bj)
#pragma unroll
                        for (int e = 0; e < 8; ++e) { const float x = v[bj][e]; v[bj][e] = x * __builtin_amdgcn_rcpf(1.f + fexp2(-1.4426950408889634f * x)); }
                }
                h16* rowp = zcol + zo(gh, row);
#pragma unroll
                for (int bj = 0; bj < 2; ++bj) {
                    u32x4 w; w[0] = pk2(v[bj][0], v[bj][1]); w[1] = pk2(v[bj][2], v[bj][3]); w[2] = pk2(v[bj][4], v[bj][5]); w[3] = pk2(v[bj][6], v[bj][7]);
                    *(u32x4*)(rowp + 32 * bj) = w;
                }
            }
    }
};

struct EpiOut0 {
    static constexpr bool PERM = true, AFTER_DRAIN = false;
    const float* xp; const float* xs; h16* X1; float* ssq1;
    __device__ __forceinline__ void operator()(const pg8::f32x4 (&acc)[2][2][4][2], const pg8::Unit& u, int wr, int wc, int fr, int fq) const {
        const int col0 = u.pn * 256 + wc * 32 + 8 * fq;
#pragma unroll
        for (int ai = 0; ai < 2; ++ai)
#pragma unroll
            for (int m = 0; m < 4; ++m) {
                const int row = u.pm * 256 + ai * 128 + wr * 64 + m * 16 + fr;
                const float* xr = row < TP ? xp + (size_t)row * 1024 : xs + (size_t)(row - TP) * 1024;
                float ss = 0.f;
#pragma unroll
                for (int bj = 0; bj < 2; ++bj) {
                    const int c = col0 + 128 * bj;
                    const f32x4 a0 = __builtin_nontemporal_load((const f32x4*)(xr + c)) + acc[ai][bj][m][0];
                    const f32x4 a1 = __builtin_nontemporal_load((const f32x4*)(xr + c + 4)) + acc[ai][bj][m][1];
                    ss += a0[0] * a0[0] + a0[1] * a0[1] + a0[2] * a0[2] + a0[3] * a0[3] + a1[0] * a1[0] + a1[1] * a1[1] + a1[2] * a1[2] + a1[3] * a1[3];
                    u32x4 w; w[0] = pk2(a0[0], a0[1]); w[1] = pk2(a0[2], a0[3]); w[2] = pk2(a1[0], a1[1]); w[3] = pk2(a1[2], a1[3]);
                    *(u32x4*)(X1 + (size_t)row * 1024 + c) = w;
                }
                ss += __shfl_xor(ss, 16); ss += __shfl_xor(ss, 32);
                if (fq == 0) atomicAdd(ssq1 + row, ss);
            }
    }
};

struct EpiOut1 {
    static constexpr bool PERM = true, AFTER_DRAIN = false;
    const h16* X1; float* out;
    __device__ __forceinline__ void operator()(const pg8::f32x4 (&acc)[2][2][4][2], const pg8::Unit& u, int wr, int wc, int fr, int fq) const {
        const int col0 = u.pn * 256 + wc * 32 + 8 * fq;
#pragma unroll
        for (int ai = 0; ai < 2; ++ai)
#pragma unroll
            for (int m = 0; m < 4; ++m) {
                const int row = u.pm * 256 + ai * 128 + wr * 64 + m * 16 + fr;
#pragma unroll
                for (int bj = 0; bj < 2; ++bj) {
                    const int c = col0 + 128 * bj;
                    const h16x8 xv = *(const h16x8*)(X1 + (size_t)row * 1024 + c);
                    f32x4 a0 = acc[ai][bj][m][0], a1 = acc[ai][bj][m][1];
#pragma unroll
                    for (int e = 0; e < 4; ++e) { a0[e] += (float)xv[e]; a1[e] += (float)xv[4 + e]; }
                    __builtin_nontemporal_store(a0, (f32x4*)(out + (size_t)row * 1024 + c));
                    __builtin_nontemporal_store(a1, (f32x4*)(out + (size_t)row * 1024 + c + 4));
                }
            }
    }
};

template <int DV, int EXP>
__device__ __forceinline__ void dense_tile(LAS const unsigned char* Kb, LAS const unsigned char* Vb, const h16x8 (&qf)[4], f32x16 (&o)[DV / 32], float& m, float& l, int lane) {
    constexpr int VP = (DV == 64) ? 192 : 320;
    const int r = lane & 31, h = lane >> 5;
    f32x16 st0, st1;
    const float base = m > -1e29f ? m : 0.f;
#pragma unroll
    for (int i = 0; i < 16; ++i) { st0[i] = -base; st1[i] = -base; }
    LAS const unsigned char* kp = Kb + r * 144 + h * 16;
#pragma unroll
    for (int ks = 0; ks < 4; ++ks) {
        const h16x8 a0 = *(LAS const h16x8*)(kp + ks * 32);
        const h16x8 a1 = *(LAS const h16x8*)(kp + 32 * 144 + ks * 32);
        st0 = mfma32(a0, qf[ks], st0);
        st1 = mfma32(a1, qf[ks], st1);
    }
#ifdef MK_SCHED_FENCE
    __builtin_amdgcn_sched_barrier(0);
#endif
    if (EXP != 1) {
        float ta = max3f(st0[0], st0[1], st1[0]), tb = max3f(st0[2], st0[3], st1[1]);
        ta = max3f(ta, st1[2], st1[3]);
#pragma unroll
        for (int i = 4; i < 16; i += 4) { ta = max3f(ta, st0[i], st0[i + 1]); tb = max3f(tb, st0[i + 2], st0[i + 3]); ta = max3f(ta, st1[i], st1[i + 1]); tb = max3f(tb, st1[i + 2], st1[i + 3]); }
        const float tm = swapmax32(max2f(ta, tb));
        const float mrel = m - base;
        const float mn = max2f(tm, mrel);
        m = base + mn;
        float rs = 0.f;
        const float alpha = fexp2(mrel - mn);
#pragma unroll
        for (int i = 0; i < 16; ++i) { st0[i] = fexp2(st0[i] - mn); st1[i] = fexp2(st1[i] - mn); rs += st0[i] + st1[i]; }
        l = l * alpha + rs;
        if (__builtin_amdgcn_ballot_w64(mn != 0.f) != 0) {
#pragma unroll
            for (int db = 0; db < DV / 32; ++db)
#pragma unroll
                for (int i = 0; i < 16; ++i) o[db][i] *= alpha;
        }
    } else { l += 1.f; }
    h16x8 pf[4];
#pragma unroll
    for (int j = 0; j < 8; ++j) { pf[0][j] = (h16)st0[j]; pf[1][j] = (h16)st0[8 + j]; pf[2][j] = (h16)st1[j]; pf[3][j] = (h16)st1[8 + j]; }
    if (EXP == 3) { o[0][0] += (float)pf[0][0] + (float)pf[1][1] + (float)pf[2][2] + (float)pf[3][3]; return; }
    const int i16 = r & 15, q = i16 >> 2, p = i16 & 3, ch = r >> 4;
    LAS const unsigned char* vp = Vb + (4 * h + q) * VP + (16 * ch + 4 * p) * 2;
#ifdef MK_SCHED_FENCE
    __builtin_amdgcn_sched_barrier(0);
#endif
#pragma unroll
    for (int db = 0; db < DV / 32; ++db)
#pragma unroll
        for (int kk = 0; kk < 4; ++kk) {
            const h16x4 lo = tr16(vp + (16 * kk) * VP + db * 64);
            const h16x4 hi = tr16(vp + (16 * kk + 8) * VP + db * 64);
            const h16x8 vf = {lo[0], lo[1], lo[2], lo[3], hi[0], hi[1], hi[2], hi[3]};
            o[db] = mfma32(vf, pf[kk], o[db]);
            if (DV == 128 && kk == 3) __builtin_amdgcn_sched_barrier(0);
        }
}

template <int EXP>
__device__ __forceinline__ void dense_tile_h(LAS const unsigned char* Kb, LAS const unsigned char* Vb, const h16x8 (&qf)[4], f32x16 (&o)[4], float& m, float& l, int lane) {
    constexpr int VP = 320;
    const int r = lane & 31, h = lane >> 5;
    const int i16 = r & 15, q = i16 >> 2, p = i16 & 3, ch = r >> 4;
    LAS const unsigned char* vp = Vb + (4 * h + q) * VP + (16 * ch + 4 * p) * 2;
    LAS const unsigned char* kp = Kb + r * 144 + h * 16;
    const float base = m > -1e29f ? m : 0.f;
    f32x16 sth[2];
#pragma unroll
    for (int kbh = 0; kbh < 2; ++kbh) {
#pragma unroll
        for (int i = 0; i < 16; ++i) sth[kbh][i] = -base;
#pragma unroll
        for (int ks = 0; ks < 4; ++ks) sth[kbh] = mfma32(*(LAS const h16x8*)(kp + kbh * 32 * 144 + ks * 32), qf[ks], sth[kbh]);
    }
#pragma unroll
    for (int kbh = 0; kbh < 2; ++kbh) {
        f32x16& st = sth[kbh];
        float tm = max3f(st[0], st[1], st[2]);
#pragma unroll
        for (int i = 3; i < 15; i += 2) tm = max3f(tm, st[i], st[i + 1]);
        tm = swapmax32(max2f(tm, st[15]));
        const float mrel = m - base;
        const float mn = max2f(tm, mrel);
        m = base + mn;
        const float alpha = fexp2(mrel - mn);
        float rs = 0.f;
#pragma unroll
        for (int i = 0; i < 16; ++i) { st[i] = fexp2(st[i] - mn); rs += st[i]; }
        l = l * alpha + rs;
        if (__builtin_amdgcn_ballot_w64(alpha != 1.f) != 0) {
#pragma unroll
            for (int db = 0; db < 4; ++db)
#pragma unroll
                for (int i = 0; i < 16; ++i) o[db][i] *= alpha;
        }
        h16x8 pf[2];
#pragma unroll
        for (int j = 0; j < 8; ++j) { pf[0][j] = (h16)st[j]; pf[1][j] = (h16)st[8 + j]; }
#pragma unroll
        for (int db = 0; db < 4; ++db)
#pragma unroll
            for (int s2 = 0; s2 < 2; ++s2) {
                const int kk = 2 * kbh + s2;
                const h16x4 lo = tr16(vp + (16 * kk) * VP + db * 64);
                const h16x4 hi = tr16(vp + (16 * kk + 8) * VP + db * 64);
                const h16x8 vf = {lo[0], lo[1], lo[2], lo[3], hi[0], hi[1], hi[2], hi[3]};
                o[db] = mfma32(vf, pf[s2], o[db]);
            }
    }
}

template <int DV, int NMAP, int EXP>
__device__ __forceinline__ void dense_unit(const h16* __restrict__ Z, h16* __restrict__ MIX, int tseq, int S, int qb, int qcol, int kcol, int vcol, int ocol, int gcol,
                                           float lam, const float* __restrict__ subln, LAS unsigned char* lds, int tid_in, float* dbg = nullptr) {
    constexpr int VP = (DV == 64) ? 192 : 320;
    constexpr int KBB = 64 * 144, VBB = 64 * VP, NV = DV / 64;
    int tid_ = tid_in * 64 + opaque_lane();
    const int tid = tid_, lane = tid & 63, wave = tid >> 6, r = lane & 31, h = lane >> 5;
    const int tq = tseq + qb * 256 + wave * 32 + r;
    const int NT = S >> 6;
    LAS h16x8* stl = (LAS h16x8*)(lds + 2 * KBB + 2 * VBB + wave * 8192) + lane;
    const int kkey = tid >> 3, kch = tid & 7;
    const int vkey = (DV == 64) ? (tid >> 3) : (tid >> 4), vch = (DV == 64) ? (tid & 7) : (tid & 15);
#pragma unroll 1
    for (int mp = 0; mp < NMAP; ++mp) {
        h16x8 qf[4];
        {
            const unsigned qoff = zo((qcol >> 6) + mp, tq) + 8 * h;
#pragma unroll
            for (int ks = 0; ks < 4; ++ks) qf[ks] = *(const h16x8*)(Z + (qoff + 16 * ks));
        }
        f32x16 o[DV / 32];
#pragma unroll
        for (int db = 0; db < DV / 32; ++db)
#pragma unroll
            for (int i = 0; i < 16; ++i) o[db][i] = 0.f;
        float m = -1e30f, l = 0.f;
        const unsigned koff = zo((kcol >> 6) + mp, tseq + kkey) + kch * 8;
        const unsigned voff = zo((vcol >> 6) + (vch >> 3), tseq + vkey) + (vch & 7) * 8;
        u32x4 kr, vr[NV];
        kr = *(const u32x4*)(Z + koff);
#pragma unroll
        for (int i = 0; i < NV; ++i) vr[i] = *(const u32x4*)(Z + (voff + (unsigned)(32 * i) * 64u));
        __syncthreads();
        *(LAS u32x4*)(lds + kkey * 144 + kch * 16) = kr;
#pragma unroll
        for (int i = 0; i < NV; ++i) *(LAS u32x4*)(lds + 2 * KBB + (vkey + 32 * i) * VP + vch * 16) = vr[i];
        __syncthreads();
        if (EXP == 0) {
            u32x4 kr2, vr2[NV];
            asm volatile("" ::: "memory");
            kr = *(const u32x4*)(Z + (koff + 64u * 64u));
#pragma unroll
            for (int i = 0; i < NV; ++i) vr[i] = *(const u32x4*)(Z + (voff + (unsigned)(64 + 32 * i) * 64u));
#pragma unroll 1
            for (int j = 0; j < NT; j += 2) {
                if (j + 2 < NT) {
                    kr2 = *(const u32x4*)(Z + (koff + (unsigned)(64 * (j + 2)) * 64u));
#pragma unroll
                    for (int i = 0; i < NV; ++i) vr2[i] = *(const u32x4*)(Z + (voff + (unsigned)(64 * (j + 2) + 32 * i) * 64u));
                }
                if constexpr (DV == 128) dense_tile_h<EXP>(lds, lds + 2 * KBB, qf, o, m, l, lane); else dense_tile<DV, EXP>(lds, lds + 2 * KBB, qf, o, m, l, lane);
                *(LAS u32x4*)(lds + KBB + kkey * 144 + kch * 16) = kr;
#pragma unroll
                for (int i = 0; i < NV; ++i) *(LAS u32x4*)(lds + 2 * KBB + VBB + (vkey + 32 * i) * VP + vch * 16) = vr[i];
                __syncthreads();
                if (j + 3 < NT) {
                    kr = *(const u32x4*)(Z + (koff + (unsigned)(64 * (j + 3)) * 64u));
#pragma unroll
                    for (int i = 0; i < NV; ++i) vr[i] = *(const u32x4*)(Z + (voff + (unsigned)(64 * (j + 3) + 32 * i) * 64u));
                }
                if constexpr (DV == 128) dense_tile_h<EXP>(lds + KBB, lds + 2 * KBB + VBB, qf, o, m, l, lane); else dense_tile<DV, EXP>(lds + KBB, lds + 2 * KBB + VBB, qf, o, m, l, lane);
                if (j + 2 < NT) {
                    *(LAS u32x4*)(lds + kkey * 144 + kch * 16) = kr2;
#pragma unroll
                    for (int i = 0; i < NV; ++i) *(LAS u32x4*)(lds + 2 * KBB + (vkey + 32 * i) * VP + vch * 16) = vr2[i];
                }
                __syncthreads();
            }
        } else {
#pragma unroll 1
        for (int j = 0; j < NT; ++j) {
            const int cur = j & 1;
            if (EXP != 2 && j + 1 < NT) {
                kr = *(const u32x4*)(Z + (koff + (unsigned)(64 * (j + 1)) * 64u));
#pragma unroll
                for (int i = 0; i < NV; ++i) vr[i] = *(const u32x4*)(Z + (voff + (unsigned)(64 * (j + 1) + 32 * i) * 64u));
            }
            dense_tile<DV, EXP>(lds + cur * KBB, lds + 2 * KBB + cur * VBB, qf, o, m, l, lane);
            if (EXP != 2 && j + 1 < NT) {
                *(LAS u32x4*)(lds + (cur ^ 1) * KBB + kkey * 144 + kch * 16) = kr;
#pragma unroll
                for (int i = 0; i < NV; ++i) *(LAS u32x4*)(lds + 2 * KBB + (cur ^ 1) * VBB + (vkey + 32 * i) * VP + vch * 16) = vr[i];
            }
            __syncthreads();
        }
        }
        const float lt = swapsum32(l);
        const float inv = 1.f / lt;
        int he = h; asm volatile("" : "+v"(he));
        int tqe = tq; asm volatile("" : "+v"(tqe));
        const float* sl2 = subln; asm volatile("" : "+s"(sl2));
#ifdef DBG
        if (NMAP == 2 && dbg) {
#pragma unroll
            for (int db = 0; db < DV / 32; ++db)
#pragma unroll
                for (int g4 = 0; g4 < 4; ++g4) {
                    const int d0 = 32 * db + 8 * g4 + 4 * he;
                    f32x4 v; v[0] = o[db][4 * g4] * inv; v[1] = o[db][4 * g4 + 1] * inv; v[2] = o[db][4 * g4 + 2] * inv; v[3] = o[db][4 * g4 + 3] * inv;
                    *(f32x4*)(dbg + ((unsigned)tqe * 1024 + mp * 512 + (ocol - 512) + d0)) = v;
                }
        }
#endif
        if (NMAP == 2 && mp == 0) {
#pragma unroll
            for (int db = 0; db < DV / 32; ++db)
#pragma unroll
                for (int c = 0; c < 2; ++c) {
                    h16x8 hv;
#pragma unroll
                    for (int jj = 0; jj < 8; ++jj) hv[jj] = (h16)(o[db][8 * c + jj] * inv);
                    stl[(db * 2 + c) * 64] = hv;
                }
        } else if (NMAP == 1) {
#pragma unroll
            for (int db = 0; db < DV / 32; ++db)
#pragma unroll
                for (int g4 = 0; g4 < 4; ++g4) {
                    const int d0 = 32 * db + 8 * g4 + 4 * he;
                    const h16x4 gt = *(const h16x4*)(Z + (zo((gcol >> 6) + (db >> 1), tqe) + (d0 & 63)));
                    u32x2 w;
                    w[0] = pk2(o[db][4 * g4 + 0] * inv * (float)gt[0], o[db][4 * g4 + 1] * inv * (float)gt[1]);
                    w[1] = pk2(o[db][4 * g4 + 2] * inv * (float)gt[2], o[db][4 * g4 + 3] * inv * (float)gt[3]);
                    *(u32x2*)(MIX + (unsigned)tqe * 1024 + ocol + d0) = w;
                }
        } else {
            float ss = 0.f;
#pragma unroll
            for (int db = 0; db < DV / 32; ++db)
#pragma unroll
                for (int c = 0; c < 2; ++c) {
                    const h16x8 hv = stl[(db * 2 + c) * 64];
#pragma unroll
                    for (int jj = 0; jj < 8; ++jj) {
                        const float a = (float)hv[jj] - lam * (o[db][8 * c + jj] * inv);
                        o[db][8 * c + jj] = a;
                        ss += a * a;
                    }
                }
            ss += __shfl_xor(ss, 32);
            const float rn = __builtin_amdgcn_rsqf(ss * (1.f / (float)DV) + EPS) * 0.8f;
#pragma unroll
            for (int db = 0; db < DV / 32; ++db)
#pragma unroll
                for (int g4 = 0; g4 < 4; ++g4) {
                    const int d0 = 32 * db + 8 * g4 + 4 * he;
                    const h16x4 gt = *(const h16x4*)(Z + (zo((gcol >> 6) + (db >> 1), tqe) + (d0 & 63)));
                    const f32x4 sg = *(const f32x4*)(sl2 + d0);
                    u32x2 w;
                    w[0] = pk2(o[db][4 * g4 + 0] * rn * sg[0] * (float)gt[0], o[db][4 * g4 + 1] * rn * sg[1] * (float)gt[1]);
                    w[1] = pk2(o[db][4 * g4 + 2] * rn * sg[2] * (float)gt[2], o[db][4 * g4 + 3] * rn * sg[3] * (float)gt[3]);
                    *(u32x2*)(MIX + (unsigned)tqe * 1024 + ocol + d0) = w;
                    if (g4 == 1 || g4 == 3) asm volatile("" : "+v"(he), "+v"(tqe) : "v"(w[1]));
                }
        }
    }
}

__device__ __forceinline__ void a2_tile(LAS const unsigned char* Kb, LAS const unsigned char* Vb, const h16x8 (&qf)[2][4], f32x16 (&o)[2][2], float (&m)[2], float (&l)[2], int lane) {
    constexpr int VP = 192;
    const int r = lane & 31, h = lane >> 5;
    f32x16 st0[2], st1[2]; float base[2];
#pragma unroll
    for (int q2 = 0; q2 < 2; ++q2) {
        base[q2] = m[q2] > -1e29f ? m[q2] : 0.f;
#pragma unroll
        for (int i = 0; i < 16; ++i) { st0[q2][i] = -base[q2]; st1[q2][i] = -base[q2]; }
    }
    LAS const unsigned char* kp = Kb + r * 144 + h * 16;
#pragma unroll
    for (int ks = 0; ks < 4; ++ks) {
        const h16x8 a0 = *(LAS const h16x8*)(kp + ks * 32);
        const h16x8 a1 = *(LAS const h16x8*)(kp + 32 * 144 + ks * 32);
#pragma unroll
        for (int q2 = 0; q2 < 2; ++q2) { st0[q2] = mfma32(a0, qf[q2][ks], st0[q2]); st1[q2] = mfma32(a1, qf[q2][ks], st1[q2]); }
    }
    h16x8 pf[2][4];
#pragma unroll
    for (int q2 = 0; q2 < 2; ++q2) {
        f32x16& s0 = st0[q2]; f32x16& s1 = st1[q2];
        float ta = max3f(s0[0], s0[1], s1[0]), tb = max3f(s0[2], s0[3], s1[1]);
        ta = max3f(ta, s1[2], s1[3]);
#pragma unroll
        for (int i = 4; i < 16; i += 4) { ta = max3f(ta, s0[i], s0[i + 1]); tb = max3f(tb, s0[i + 2], s0[i + 3]); ta = max3f(ta, s1[i], s1[i + 1]); tb = max3f(tb, s1[i + 2], s1[i + 3]); }
        const float tm = swapmax32(max2f(ta, tb));
        const float mrel = m[q2] - base[q2];
        const float mn = max2f(tm, mrel);
        m[q2] = base[q2] + mn;
        const float alpha = fexp2(mrel - mn);
        float rs = 0.f;
#pragma unroll
        for (int i = 0; i < 16; ++i) { s0[i] = fexp2(s0[i] - mn); s1[i] = fexp2(s1[i] - mn); rs += s0[i] + s1[i]; }
        l[q2] = l[q2] * alpha + rs;
        if (__builtin_amdgcn_ballot_w64(alpha != 1.f) != 0) {
#pragma unroll
            for (int db = 0; db < 2; ++db)
#pragma unroll
                for (int i = 0; i < 16; ++i) o[q2][db][i] *= alpha;
        }
#pragma unroll
        for (int j = 0; j < 8; ++j) { pf[q2][0][j] = (h16)s0[j]; pf[q2][1][j] = (h16)s0[8 + j]; pf[q2][2][j] = (h16)s1[j]; pf[q2][3][j] = (h16)s1[8 + j]; }
    }
    const int i16 = r & 15, q = i16 >> 2, p = i16 & 3, ch = r >> 4;
    LAS const unsigned char* vp = Vb + (4 * h + q) * VP + (16 * ch + 4 * p) * 2;
#pragma unroll
    for (int db = 0; db < 2; ++db)
#pragma unroll
        for (int kk = 0; kk < 4; ++kk) {
            const h16x4 lo = tr16(vp + (16 * kk) * VP + db * 64);
            const h16x4 hi = tr16(vp + (16 * kk + 8) * VP + db * 64);
            const h16x8 vf = {lo[0], lo[1], lo[2], lo[3], hi[0], hi[1], hi[2], hi[3]};
#pragma unroll
            for (int q2 = 0; q2 < 2; ++q2) o[q2][db] = mfma32(vf, pf[q2][kk], o[q2][db]);
        }
}

__device__ __forceinline__ void dense_unit_a2(const h16* __restrict__ Z, h16* __restrict__ MIX, int tseq, int S, int qb, int qslot, int kslot, int vslot, int ocol, int gslot,
                                              LAS unsigned char* lds, int wave_in) {
    constexpr int VP = 192, KBB = 64 * 144, VBB = 64 * VP;
    const int tid = wave_in * 64 + opaque_lane();
    const int lane = tid & 63, wave = tid >> 6, r = lane & 31, h = lane >> 5;
    const int tq0 = tseq + qb * 512 + wave * 64 + r;
    const int NT = S >> 6;
    const int kkey = tid >> 3, kch = tid & 7;
    h16x8 qf[2][4];
#pragma unroll
    for (int q2 = 0; q2 < 2; ++q2) {
        const unsigned qoff = zo(qslot, tq0 + 32 * q2) + 8 * h;
#pragma unroll
        for (int ks = 0; ks < 4; ++ks) qf[q2][ks] = *(const h16x8*)(Z + (qoff + 16 * ks));
    }
    f32x16 o[2][2]; float m[2], l[2];
#pragma unroll
    for (int q2 = 0; q2 < 2; ++q2) {
#pragma unroll
        for (int i = 0; i < 16; ++i) { o[q2][0][i] = 0.f; o[q2][1][i] = 0.f; }
        m[q2] = -1e30f; l[q2] = 0.f;
    }
    const unsigned koff = zo(kslot, tseq + kkey) + kch * 8;
    const unsigned voff = zo(vslot, tseq + kkey) + kch * 8;
    u32x4 kr, vr;
    kr = *(const u32x4*)(Z + koff); vr = *(const u32x4*)(Z + voff);
    __syncthreads();
    *(LAS u32x4*)(lds + kkey * 144 + kch * 16) = kr;
    *(LAS u32x4*)(lds + 2 * KBB + kkey * VP + kch * 16) = vr;
    __syncthreads();
#pragma unroll 1
    for (int j = 0; j < NT; ++j) {
        const int cur = j & 1;
        if (j + 1 < NT) { kr = *(const u32x4*)(Z + (koff + (unsigned)(64 * (j + 1)) * 64u)); vr = *(const u32x4*)(Z + (voff + (unsigned)(64 * (j + 1)) * 64u)); }
        a2_tile(lds + cur * KBB, lds + 2 * KBB + cur * VBB, qf, o, m, l, lane);
        if (j + 1 < NT) {
            *(LAS u32x4*)(lds + (cur ^ 1) * KBB + kkey * 144 + kch * 16) = kr;
            *(LAS u32x4*)(lds + 2 * KBB + (cur ^ 1) * VBB + kkey * VP + kch * 16) = vr;
        }
        __syncthreads();
    }
    int he = h, tqe = tq0; asm volatile("" : "+v"(he), "+v"(tqe));
#pragma unroll
    for (int q2 = 0; q2 < 2; ++q2) {
        const float lt = swapsum32(l[q2]);
        const float inv = 1.f / lt;
        const int tq = tqe + 32 * q2;
#pragma unroll
        for (int db = 0; db < 2; ++db)
#pragma unroll
            for (int g4 = 0; g4 < 4; ++g4) {
                const int d0 = 32 * db + 8 * g4 + 4 * he;
                const h16x4 gt = *(const h16x4*)(Z + (zo(gslot, tq) + d0));
                u32x2 w;
                w[0] = pk2(o[q2][db][4 * g4 + 0] * inv * (float)gt[0], o[q2][db][4 * g4 + 1] * inv * (float)gt[1]);
                w[1] = pk2(o[q2][db][4 * g4 + 2] * inv * (float)gt[2], o[q2][db][4 * g4 + 3] * inv * (float)gt[3]);
                *(u32x2*)(MIX + ((unsigned)tq * 1024u + ocol + d0)) = w;
            }
    }
}

template <int EXP>
__device__ __forceinline__ void dense_phase(const Params& P, LAS unsigned char* lds, int tid_in) {
    const h16* Z = (const h16*)(P.ws + WS_Z);
    h16* MIX = (h16*)(P.ws + WS_MIX);
    tid_in = __builtin_amdgcn_readfirstlane(tid_in >> 6);
    const float lam = ((const float*)(P.ws + WS_CTL))[0];
    const float* subln = P.in[13];
    for (int u0 = blockIdx.x; u0 < 2560; u0 += gridDim.x) {
        const int u = gridDim.x == 256 ? ((u0 & ~255) | ((u0 & 7) << 5) | ((u0 & 255) >> 3)) : u0;
#ifdef DENSE_ONLY_A
        if (false) {
#else
        if (u < 1280) {
#endif
            int tseq, S, hb, qb;
            if (u < 256) { const int b = u >> 6; hb = (u >> 4) & 3; qb = u & 15; tseq = TP + b * 4096; S = 4096; }
            else { const int v = u - 256; const int b = 31 - (v >> 5); hb = (v >> 3) & 3; qb = v & 7; tseq = b * 2048; S = 2048; }
            dense_unit<128, 2, EXP>(Z, MIX, tseq, S, qb, 768 + hb * 128, 1280 + hb * 128, 1792 + hb * 128, 512 + hb * 128, 2304 + 512 + hb * 128, lam, subln, lds, tid_in,
#if defined(DBG) && DBG == 3
                               P.out
#else
                               nullptr
#endif
                               );
        } else {
#ifndef DENSE_ONLY_B
            int tseq, S, hq, qb;
            if (u < 1536) { const int v = u - 1280; const int b = v >> 6; hq = (v >> 3) & 7; qb = v & 7; tseq = TP + b * 4096; S = 4096; }
            else { const int v = u - 1536; const int b = 31 - (v >> 5); hq = (v >> 2) & 7; qb = v & 3; tseq = b * 2048; S = 2048; }
            dense_unit_a2(Z, MIX, tseq, S, qb, hq, 8 + (hq >> 2), 10 + (hq >> 2), hq * 64, 36 + hq, lds, tid_in);
#endif
        }
    }
}

template <int NG>
__device__ __forceinline__ void banded_item(const h16* __restrict__ Z, h16* __restrict__ MIX, LAS unsigned char* ost, LAS float* mst, LAS float* lst, LAS unsigned char* vl, LAS unsigned char* kl, LAS const unsigned char* vp,
                                            int T0, int seqbase, int off0, int L, int dsh, int rc, int mblk0, int head, bool first, bool last, int lane) {
    const int r = lane & 31, h = lane >> 5;
    const int qslot = head, kslot = 16 + head, vslot = 32 + head, gslot = 48 + head;
    const int mq0 = (off0 >> dsh) + mblk0 * 32;
    int tl[NG]; h16x8 qf[NG][4]; f32x16 o[NG][2]; float m[NG], l[NG];
#pragma unroll
    for (int g = 0; g < NG; ++g) {
        tl[g] = ((mblk0 * 32 + 32 * g + r) << dsh) + rc;
        const h16* qrow = Z + (zo(qslot, T0 + tl[g]) + 8 * h);
#pragma unroll
        for (int ks = 0; ks < 4; ++ks) qf[g][ks] = *(const h16x8*)(qrow + 16 * ks);
    }
#pragma unroll
    for (int g = 0; g < NG; ++g) {
        if (first) {
#pragma unroll
            for (int i = 0; i < 16; ++i) { o[g][0][i] = 0.f; o[g][1][i] = 0.f; }
            m[g] = -1e30f; l[g] = 0.f;
        } else {
            m[g] = mst[tl[g]]; const float lt0 = lst[tl[g]]; l[g] = h == 0 ? lt0 : 0.f;
#pragma unroll
            for (int db = 0; db < 2; ++db)
#pragma unroll
                for (int g4 = 0; g4 < 4; ++g4) {
                    const h16x4 sv = *(LAS const h16x4*)(ost + tl[g] * 136 + (32 * db + 8 * g4 + 4 * h) * 2);
#pragma unroll
                    for (int e = 0; e < 4; ++e) o[g][db][4 * g4 + e] = (float)sv[e] * lt0;
                }
        }
    }
    int kb_lo = -2, kb_hi = 1 + NG;
    while (mq0 + 32 * kb_lo < 0) ++kb_lo;
    while (mq0 + 32 * kb_hi >= L) --kb_hi;
    u32x4 krn[4], vrn[4];
#define BLOAD(kb) do { \
        _Pragma("unroll") for (int i = 0; i < 4; ++i) { const int c = lane + 64 * i; \
            const unsigned ro = (unsigned)(seqbase + ((mq0 + 32 * (kb) + (c >> 3)) << dsh) + rc) * 64u + 8 * (c & 7); \
            krn[i] = *(const u32x4*)(Z + ((unsigned)kslot * (unsigned)TT * 64u + ro)); \
            vrn[i] = *(const u32x4*)(Z + ((unsigned)vslot * (unsigned)TT * 64u + ro)); } } while (0)
    BLOAD(kb_lo);
#pragma unroll 1
    for (int kb = kb_lo; kb <= kb_hi; ++kb) {
#pragma unroll
        for (int i = 0; i < 4; ++i) { const int c = lane + 64 * i; *(LAS u32x4*)(vl + (c >> 3) * 192 + (c & 7) * 16) = vrn[i]; *(LAS u32x4*)(kl + (c >> 3) * 144 + (c & 7) * 16) = krn[i]; }
        asm volatile("s_waitcnt lgkmcnt(0)" ::: "memory");
        if (kb < kb_hi) BLOAD(kb + 1);
        h16x8 kf[4];
#pragma unroll
        for (int ks = 0; ks < 4; ++ks) kf[ks] = *(LAS const h16x8*)(kl + r * 144 + h * 16 + ks * 32);
        h16x8 pfg[NG][2];
#pragma unroll
        for (int g = 0; g < NG; ++g) {
            const int kr = kb - g;
            if (kr >= -2 && kr <= 2) {
                f32x16 st;
#pragma unroll
                for (int i = 0; i < 16; ++i) st[i] = 0.f;
#pragma unroll
                for (int ks = 0; ks < 4; ++ks) st = mfma32(kf[ks], qf[g][ks], st);
                if (kr == -2) {
#pragma unroll
                    for (int i = 0; i < 16; ++i) { const int jj = 8 * (i >> 2) + 4 * h + (i & 3); if (jj < r) st[i] = -1e30f; }
                } else if (kr == 2) {
#pragma unroll
                    for (int i = 0; i < 16; ++i) { const int jj = 8 * (i >> 2) + 4 * h + (i & 3); if (jj > r) st[i] = -1e30f; }
                }
                float tm = max3f(st[0], st[1], st[2]);
#pragma unroll
                for (int i = 3; i < 15; i += 2) tm = max3f(tm, st[i], st[i + 1]);
                tm = swapmax32(max2f(tm, st[15]));
                const float mn = max2f(m[g], tm);
                const float alpha = fexp2(m[g] - mn);
                m[g] = mn;
                float rs = 0.f;
#pragma unroll
                for (int i = 0; i < 16; ++i) { st[i] = fexp2(st[i] - mn); rs += st[i]; }
                l[g] = l[g] * alpha + rs;
#pragma unroll
                for (int j = 0; j < 8; ++j) { pfg[g][0][j] = (h16)st[j]; pfg[g][1][j] = (h16)st[8 + j]; }
                if (__builtin_amdgcn_ballot_w64(alpha != 1.f) != 0) {
#pragma unroll
                    for (int i = 0; i < 16; ++i) { o[g][0][i] *= alpha; o[g][1][i] *= alpha; }
                }
            }
        }
#pragma unroll
        for (int db = 0; db < 2; ++db)
#pragma unroll
            for (int s2 = 0; s2 < 2; ++s2) {
                const h16x4 lo = tr16(vp + (16 * s2) * 192 + db * 64);
                const h16x4 hi = tr16(vp + (16 * s2 + 8) * 192 + db * 64);
                const h16x8 vf = {lo[0], lo[1], lo[2], lo[3], hi[0], hi[1], hi[2], hi[3]};
#pragma unroll
                for (int g = 0; g < NG; ++g) {
                    const int kr = kb - g;
                    if (kr >= -2 && kr <= 2) o[g][db] = mfma32(vf, pfg[g][s2], o[g][db]);
                }
            }
        asm volatile("s_waitcnt lgkmcnt(0)" ::: "memory");
    }
#undef BLOAD
#pragma unroll
    for (int g = 0; g < NG; ++g) {
        const float lt = swapsum32(l[g]);
        const float inv = 1.f / lt;
        if (!last) {
#pragma unroll
            for (int db = 0; db < 2; ++db)
#pragma unroll
                for (int g4 = 0; g4 < 4; ++g4) {
                    u32x2 w;
                    w[0] = pk2(o[g][db][4 * g4 + 0] * inv, o[g][db][4 * g4 + 1] * inv);
                    w[1] = pk2(o[g][db][4 * g4 + 2] * inv, o[g][db][4 * g4 + 3] * inv);
                    *(LAS u32x2*)(ost + tl[g] * 136 + (32 * db + 8 * g4 + 4 * h) * 2) = w;
                }
            if (h == 0) { mst[tl[g]] = m[g]; lst[tl[g]] = lt; }
        } else {
            const int tok = T0 + tl[g];
#pragma unroll
            for (int db = 0; db < 2; ++db)
#pragma unroll
                for (int g4 = 0; g4 < 4; ++g4) {
                    const int d0 = 32 * db + 8 * g4 + 4 * h;
                    const h16x4 gt = *(const h16x4*)(Z + (zo(gslot, tok) + d0));
                    u32x2 w;
                    w[0] = pk2(o[g][db][4 * g4 + 0] * inv * (float)gt[0], o[g][db][4 * g4 + 1] * inv * (float)gt[1]);
                    w[1] = pk2(o[g][db][4 * g4 + 2] * inv * (float)gt[2], o[g][db][4 * g4 + 3] * inv * (float)gt[3]);
                    *(u32x2*)(MIX + ((unsigned)tok * 1024u + head * 64 + d0)) = w;
                }
        }
    }
}

__device__ __forceinline__ void banded_phase(const Params& P, LAS unsigned char* lds, int tid_in) {
    const h16* __restrict__ Z = (const h16*)(P.ws + WS_Z);
    h16* __restrict__ MIX = (h16*)(P.ws + WS_MIX);
    int tid_ = tid_in; asm volatile("" : "+v"(tid_));
    const int tid = tid_, lane = tid & 63, wave = __builtin_amdgcn_readfirstlane(tid >> 6), r = lane & 31, h = lane >> 5;
    LAS unsigned char* ost = lds;
    LAS float* mst = (LAS float*)(lds + 69632);
    LAS float* lst = (LAS float*)(lds + 71680);
    LAS unsigned char* vl = lds + 73728 + wave * 6144;
    LAS unsigned char* kl = lds + 122880 + wave * 4608;
    const int i16 = r & 15, tq_ = i16 >> 2, tp_ = i16 & 3, tch = r >> 4;
    LAS const unsigned char* vp = vl + (4 * h + tq_) * 192 + (16 * tch + 4 * tp_) * 2;
#pragma unroll 1
    for (int u = blockIdx.x; u < 2560; u += gridDim.x) {
        const int sp = u >> 4, head = u & 15;
        const int T0 = sp * 512;
        const int S = T0 < TP ? 2048 : 4096;
        const int seqbase = T0 & ~(S - 1), off0 = T0 - seqbase;
        banded_item<2>(Z, MIX, ost, mst, lst, vl, kl, vp, T0, seqbase, off0, S, 0, 0, 2 * wave, head, true, false, lane);
        __syncthreads();
        banded_item<2>(Z, MIX, ost, mst, lst, vl, kl, vp, T0, seqbase, off0, S >> 2, 2, wave & 3, 2 * (wave >> 2), head, false, false, lane);
        __syncthreads();
#pragma unroll 1
        for (int rd = 0; rd < 2; ++rd)
            banded_item<1>(Z, MIX, ost, mst, lst, vl, kl, vp, T0, seqbase, off0, S >> 4, 4, wave + 8 * rd, 0, head, false, true, lane);
        __syncthreads();
    }
}

#ifndef MK_SP2
#define MK_SP2 true
#endif
#ifndef MK_ALIGN
#define MK_ALIGN true
#endif
template <int LO, int HI>
__global__ void __launch_bounds__(NTHREADS, 2) fwd_kernel(Params P) {
    extern __shared__ __attribute__((aligned(16))) unsigned char lds_raw[];
    LAS unsigned char* lds = (LAS unsigned char*)lds_raw;
    constexpr int lo = LO, hi = HI;
    const int wave_s = __builtin_amdgcn_readfirstlane((int)(threadIdx.x >> 6));
#define MYTID() (wave_s * 64 + opaque_lane())
    unsigned char* ws = P.ws;
#ifdef ONLY_PHASE
#define IN(k) ((k) == ONLY_PHASE && lo <= (k) && (k) < hi)
#else
#define IN(k) (lo <= (k) && (k) < hi)
#endif
#define SEAM(k) do { if (IN(k) && IN((k) + 1)) { \
        if ((k) == 0) cg::this_grid().sync(); \
        else { \
            __syncthreads(); \
            if (MYTID() == 0) { \
                unsigned* ctr = (unsigned*)(ws + WS_BAR); \
                __builtin_amdgcn_fence(__ATOMIC_RELEASE, "agent"); \
                __hip_atomic_fetch_add(ctr, 1u, __ATOMIC_RELAXED, __HIP_MEMORY_SCOPE_AGENT); \
                const unsigned target = (unsigned)(k) * gridDim.x; \
                while (__hip_atomic_load(ctr, __ATOMIC_RELAXED, __HIP_MEMORY_SCOPE_AGENT) < target) __builtin_amdgcn_s_sleep(2); \
                __builtin_amdgcn_fence(__ATOMIC_ACQUIRE, "agent"); \
            } \
            __syncthreads(); \
        } } } while (0)
    if (IN(0)) p0_phase(P, lds, MYTID());
    SEAM(0);
    if (IN(1)) {
        pg8::Gemm g{(const pg8::bf16_t*)(ws + WS_XH), (const pg8::bf16_t*)(ws + WS_WIN0), TT, N0, DM};
        pg8::StaticOrder S; S.init(TT, N0, (int)gridDim.x, (int)blockIdx.x);
        EpiIn E{(h16*)(ws + WS_Z), N0, 0, (const float*)(ws + WS_SSQ0), P.in[5], P.in[6], P.in[7], P.in[8]};
        pg8::gemm_phase<EpiIn, pg8::StaticOrder, MK_ALIGN, MK_SP2>(lds, g, S, E, MYTID());
#if defined(MK_DUP_PHASE) && MK_DUP_PHASE == 1
        __syncthreads();
        pg8::gemm_phase<EpiIn, pg8::StaticOrder, MK_ALIGN, MK_SP2>(lds, g, S, E, MYTID());
#endif
    }
    SEAM(1);
#ifdef MK_EXP
    if (IN(2)) { dense_phase<MK_EXP>(P, lds, MYTID()); __syncthreads(); }
#endif
    if (IN(2)) dense_phase<0>(P, lds, MYTID());
#if defined(MK_DUP_PHASE) && MK_DUP_PHASE == 2
    if (IN(2)) { __syncthreads(); dense_phase<0>(P, lds, MYTID()); }
#endif
    SEAM(2);
    if (IN(3)) {
        pg8::Gemm g{(const pg8::bf16_t*)(ws + WS_MIX), (const pg8::bf16_t*)(ws + WS_WOUT0), TT, DM, DM};
        pg8::StaticOrder S; S.init(TT, DM, (int)gridDim.x, (int)blockIdx.x);
        EpiOut0 E{P.in[0], P.in[1], (h16*)(ws + WS_XH), (float*)(ws + WS_SSQ1)};
        pg8::gemm_phase<EpiOut0, pg8::StaticOrder, MK_ALIGN, MK_SP2>(lds, g, S, E, MYTID());
    }
    SEAM(3);
    if (IN(4)) {
        pg8::Gemm g{(const pg8::bf16_t*)(ws + WS_XH), (const pg8::bf16_t*)(ws + WS_WIN1), TT, N1, DM};
        pg8::StaticOrder S; S.init(TT, N1, (int)gridDim.x, (int)blockIdx.x);
        EpiIn E{(h16*)(ws + WS_Z), N1, 1, (const float*)(ws + WS_SSQ1), P.in[17], P.in[18], P.in[17], P.in[18]};
        pg8::gemm_phase<EpiIn, pg8::StaticOrder, MK_ALIGN, MK_SP2>(lds, g, S, E, MYTID());
    }
    SEAM(4);
    if (IN(5)) banded_phase(P, lds, MYTID());
#if defined(MK_DUP_PHASE) && MK_DUP_PHASE == 5
    if (IN(5)) { __syncthreads(); banded_phase(P, lds, MYTID()); }
#endif
    SEAM(5);
    if (IN(6)) {
        pg8::Gemm g{(const pg8::bf16_t*)(ws + WS_MIX), (const pg8::bf16_t*)(ws + WS_WOUT1), TT, DM, DM};
        pg8::StaticOrder S; S.init(TT, DM, (int)gridDim.x, (int)blockIdx.x);
        EpiOut1 E{(const h16*)(ws + WS_XH), P.out};
        pg8::gemm_phase<EpiOut1, pg8::StaticOrder, MK_ALIGN, MK_SP2>(lds, g, S, E, MYTID());
    }
#undef IN
#undef SEAM
}

#ifndef MK_LAUNCHES
#define MK_LAUNCHES 1
#endif
template <int LO, int HI>
static void launch_range(const Params& p0, int grid, hipStream_t stream, bool coop) {
    Params p = p0; p.ph_lo = LO; p.ph_hi = HI;
    if (coop) {
        void* args[] = {&p};
        hipError_t e = hipLaunchCooperativeKernel((const void*)fwd_kernel<LO, HI>, dim3(grid), dim3(NTHREADS), args, LDS_BYTES, stream);
        if (e != hipSuccess) fprintf(stderr, "cooperative launch failed: %s (grid %d)\n", hipGetErrorString(e), grid);
    } else {
        hipLaunchKernelGGL((fwd_kernel<LO, HI>), dim3(grid), dim3(NTHREADS), LDS_BYTES, stream, p);
    }
}
template <int LO, int HI>
static bool prep_kernel(int& per_cu) {
    if (hipFuncSetAttribute((const void*)fwd_kernel<LO, HI>, hipFuncAttributeMaxDynamicSharedMemorySize, LDS_BYTES) != hipSuccess) { fprintf(stderr, "kernel_launch: hipFuncSetAttribute failed\n"); return false; }
    int pc = 0;
    if (hipOccupancyMaxActiveBlocksPerMultiprocessor(&pc, (const void*)fwd_kernel<LO, HI>, NTHREADS, LDS_BYTES) != hipSuccess || pc < 1) { fprintf(stderr, "kernel_launch: occupancy query gave %d\n", pc); pc = 1; (void)hipGetLastError(); }
    if (pc < per_cu) per_cu = pc;
    return true;
}
extern "C" void kernel_launch(void* const* d_in, const int* in_sizes, int n_in, void* d_out, int out_size, void* d_ws, size_t ws_size, hipStream_t stream) {
    static int grid = 0;
    if (grid == 0) {
        int dev = 0, cus = 0, per_cu = 64;
        if (hipGetDevice(&dev) != hipSuccess || hipDeviceGetAttribute(&cus, hipDeviceAttributeMultiprocessorCount, dev) != hipSuccess) { fprintf(stderr, "kernel_launch: device query failed\n"); grid = -1; return; }
        bool ok = true;
#if MK_LAUNCHES == 1
        ok = prep_kernel<0, 7>(per_cu);
#else
        ok = prep_kernel<0, 1>(per_cu) && prep_kernel<1, 2>(per_cu) && prep_kernel<2, 3>(per_cu) && prep_kernel<3, 4>(per_cu) && prep_kernel<4, 5>(per_cu) && prep_kernel<5, 6>(per_cu) && prep_kernel<6, 7>(per_cu);
#endif
        if (!ok) { grid = -1; return; }
        grid = cus * per_cu;
        if (ws_size < WS_END) fprintf(stderr, "kernel_launch: workspace too small: %zu < %zu\n", ws_size, (size_t)WS_END);
    }
    if (grid < 0) return;
    Params p{};
    for (int i = 0; i < 19; ++i) p.in[i] = (const float*)d_in[i];
    p.out = (float*)d_out; p.ws = (unsigned char*)d_ws;
    for (int j = 0; j < 8; ++j) p.frq[j] = pow(500000.0, -(double)(2 * j) / 16.0);
    for (int j = 0; j < 16; ++j) p.frq[8 + j] = pow(10000.0, -(double)(2 * j) / 32.0);
#if MK_LAUNCHES == 1
    (void)hipMemsetAsync((unsigned char*)d_ws + WS_BAR, 0, 256, stream);
    launch_range<0, 7>(p, grid, stream, true);
#else
    launch_range<0, 1>(p, grid, stream, false); launch_range<1, 2>(p, grid, stream, false); launch_range<2, 3>(p, grid, stream, false); launch_range<3, 4>(p, grid, stream, false);
    launch_range<4, 5>(p, grid, stream, false); launch_range<5, 6>(p, grid, stream, false); launch_range<6, 7>(p, grid, stream, false);
#endif
}
```

```cpp
#include <hip/hip_runtime.h>
#include <hip/hip_cooperative_groups.h>
#include <cstdio>
#include <cstdint>
#include <cmath>
namespace cg = cooperative_groups;
namespace pg8 {
#define PG8_LAS __attribute__((address_space(3)))
typedef unsigned short bf16_t;
typedef _Float16 bf16x8 __attribute__((ext_vector_type(8)));
typedef float f32x4 __attribute__((ext_vector_type(4)));
typedef unsigned u32x4 __attribute__((ext_vector_type(4)));
constexpr int BM = 256, BK = 64, HALF = 128, HTB = HALF * BK * 2  , STAGE_BYTES = 8 * HTB, NXCD = 8, WGM = 8;

__host__ __device__ __forceinline__ int lds_byte(int r, int c) { const int st = (r >> 4) * 2 + (c >> 5), rr = r & 15, cc = c & 31, ob = rr * 64 + cc * 2; return st * 1024 + (ob ^ (((ob >> 9) & 1) << 5)); }
__host__ __device__ __forceinline__ void stage_rc(int b, int& R, int& C) { const int st = b / 1024, sb = b % 1024, swz = sb ^ (((sb >> 9) & 1) << 5); R = (st >> 1) * 16 + swz / 64; C = (st & 1) * 32 + (swz % 64) / 2; }
__host__ __device__ __forceinline__ int perm32(int rho) { const int n = rho >> 4, i = rho & 15; return 8 * (i >> 2) + 4 * n + (i & 3); }

struct Unit { int pm, pn; };
struct Gemm { const bf16_t* A; const bf16_t* Bt; int M, N, K; };

struct StaticOrder {
    int nM, nN, nwg, G, c;
    __host__ __device__ void init(int M, int N, int G_, int c_) { nM = M / BM; nN = N / BM; nwg = nM * nN; G = G_; c = c_; }
    __host__ __device__ bool next(int i, Unit& u) const {
        const long L = (long)i * G + c; if (L >= nwg) return false;
        int wgid = (int)L; { const int q = nwg / NXCD, r = nwg % NXCD, xcd = wgid % NXCD, off = wgid / NXCD; wgid = (xcd < r ? xcd * (q + 1) : r * (q + 1) + (xcd - r) * q) + off; }
        const int nig = WGM * nN, gid = wgid / nig, fm = gid * WGM, gsz = (nM - fm) < WGM ? (nM - fm) : WGM;
        u.pm = fm + ((wgid % nig) % gsz); u.pn = (wgid % nig) / gsz; return true;
    }
    __device__ __forceinline__ void a_ready(const Unit&) const {}
    __device__ __forceinline__ void done(const Unit&) const {}
};
template <class Epi, class Sched, bool ALIGN_EPI = false, bool SP2 = false>
__device__ __forceinline__ void gemm_phase(PG8_LAS unsigned char* lds, const Gemm g, const Sched& S, const Epi& E, int tid_in) {
    int tid_ = tid_in; asm volatile("" : "+v"(tid_));
    const int tid = tid_, wid = __builtin_amdgcn_readfirstlane(tid >> 6), lane = tid & 63, wr = wid >> 2, wc = wid & 3, fr = lane & 15, fq = lane >> 4;
    const int K = g.K, nt = K / BK;
    unsigned voffA[2], voffB[2];
#pragma unroll
    for (int i = 0; i < 2; ++i) { int R, C; stage_rc(tid * 16 + i * 8192, R, C); const int Rb = Epi::PERM ? ((R & ~31) + perm32(R & 31)) : R;
        voffA[i] = (unsigned)(R * K + C) * 2u; voffB[i] = (unsigned)(Rb * K + C) * 2u; }
    const size_t kstep = (size_t)(BK * 2);
    const size_t hstep = (size_t)HALF * K * 2;
    const size_t tstep = 2 * hstep;
    const unsigned ldsw = (unsigned)wid * 1024u;
    const int aoff = lds_byte(wr * 64 + fr, fq * 8), boff = lds_byte(wc * 32 + fr, fq * 8);
#define PG8_SA(b, h) (((b) * 2 + (h)) * HTB)
#define PG8_SB(b, h) ((4 + (b) * 2 + (h)) * HTB)
#define PG8_STAGE(bufoff, gbase, voff) do { _Pragma("unroll") for (int _i = 0; _i < 2; ++_i) \
        __builtin_amdgcn_global_load_lds((const unsigned*)((const char*)(gbase) + (voff)[_i]), (PG8_LAS unsigned*)(lds + (bufoff) + ldsw + _i * 8192), 16, 0, 0); } while (0)
#define PG8_LDA(dst, b, h) do { _Pragma("unroll") for (int m = 0; m < 4; ++m) _Pragma("unroll") for (int k = 0; k < 2; ++k) dst[m][k] = *(const PG8_LAS bf16x8*)(lds + PG8_SA(b, h) + aoff + m * 2048 + k * 1024); } while (0)
#define PG8_LDB(dst, b, h) do { _Pragma("unroll") for (int n = 0; n < 2; ++n) _Pragma("unroll") for (int k = 0; k < 2; ++k) dst[n][k] = *(const PG8_LAS bf16x8*)(lds + PG8_SB(b, h) + boff + n * 2048 + k * 1024); } while (0)
#define PG8_MMA(ai, bj, At, Bt) do { __builtin_amdgcn_s_setprio(1); _Pragma("unroll") for (int m = 0; m < 4; ++m) _Pragma("unroll") for (int n = 0; n < 2; ++n) _Pragma("unroll") for (int k = 0; k < 2; ++k) \
        acc[ai][bj][m][n] = __builtin_amdgcn_mfma_f32_16x16x32_f16(Bt[n][k], At[m][k], acc[ai][bj][m][n], 0, 0, 0); __builtin_amdgcn_s_setprio(0); } while (0)
#define PG8_WAIT_V(n) asm volatile("s_waitcnt vmcnt(" #n ")" ::: "memory")
#define PG8_WAIT_L(n) asm volatile("s_waitcnt lgkmcnt(" #n ")" ::: "memory")
#define PG8_BAR __builtin_amdgcn_s_barrier()
#define PG8_SCHED __builtin_amdgcn_sched_barrier(0)
    Unit cur, nxt; int ui = 0;
    if (!S.next(0, cur)) return;
    f32x4 acc[2][2][4][2];
#pragma unroll
    for (int a = 0; a < 2; ++a)
#pragma unroll
        for (int b = 0; b < 2; ++b)
#pragma unroll
            for (int m = 0; m < 4; ++m)
#pragma unroll
                for (int n = 0; n < 2; ++n) acc[a][b][m][n] = (f32x4){0.f, 0.f, 0.f, 0.f};
    bf16x8 At[4][2], B0[2][2], B1[2][2];
    const char* cA = (const char*)g.A + (size_t)cur.pm * tstep; const char* cB = (const char*)g.Bt + (size_t)cur.pn * tstep;
    S.a_ready(cur);
    if constexpr (SP2) {
        PG8_STAGE(PG8_SB(0, 0), cB, voffB); PG8_STAGE(PG8_SB(0, 1), cB + hstep, voffB); PG8_STAGE(PG8_SA(0, 0), cA, voffA); PG8_STAGE(PG8_SA(0, 1), cA + hstep, voffA);
        if (wr == 1) PG8_BAR;
        PG8_WAIT_V(2); PG8_BAR;
        PG8_STAGE(PG8_SB(1, 0), cB + kstep, voffB); PG8_STAGE(PG8_SA(1, 0), cA + kstep, voffA); PG8_STAGE(PG8_SB(1, 1), cB + hstep + kstep, voffB);
        PG8_WAIT_V(6); PG8_BAR;
    } else {
        PG8_STAGE(PG8_SB(0, 0), cB, voffB); PG8_STAGE(PG8_SA(0, 0), cA, voffA); PG8_STAGE(PG8_SB(0, 1), cB + hstep, voffB); PG8_STAGE(PG8_SA(0, 1), cA + hstep, voffA);
        if (wr == 1) PG8_BAR;
        PG8_WAIT_V(4); PG8_BAR;
        PG8_STAGE(PG8_SB(1, 0), cB + kstep, voffB); PG8_STAGE(PG8_SA(1, 0), cA + kstep, voffA); PG8_STAGE(PG8_SB(1, 1), cB + hstep + kstep, voffB);
        PG8_WAIT_V(6); PG8_BAR;
    }
    for (;;) {
        const bool has_next = S.next(ui + 1, nxt);
        const char* nA = has_next ? (const char*)g.A + (size_t)nxt.pm * tstep : cA; const char* nB = has_next ? (const char*)g.Bt + (size_t)nxt.pn * tstep : cB;
        for (int t = 0; t < nt; t += 2) {
            const bool last = (t == nt - 2);
            const char* a1 = cA + (size_t)(t + 1) * kstep;
            const char* a2 = last ? nA : cA + (size_t)(t + 2) * kstep; const char* b2 = last ? nB : cB + (size_t)(t + 2) * kstep;
            const char* a3 = a2 + kstep; const char* b3 = b2 + kstep;
            if (last && has_next) S.a_ready(nxt);
            if constexpr (SP2) {
            PG8_LDB(B0, 0, 0); PG8_LDB(B1, 0, 1); PG8_SCHED; PG8_LDA(At, 0, 0); PG8_STAGE(PG8_SA(1, 1), a1 + hstep, voffA);
            PG8_WAIT_V(8); PG8_WAIT_L(0); PG8_BAR; PG8_MMA(0, 0, At, B0); PG8_MMA(0, 1, At, B1); PG8_BAR; PG8_SCHED;
            PG8_LDA(At, 0, 1); PG8_STAGE(PG8_SB(0, 0), b2, voffB); PG8_STAGE(PG8_SB(0, 1), b2 + hstep, voffB); PG8_STAGE(PG8_SA(0, 0), a2, voffA);
            PG8_WAIT_V(8); PG8_WAIT_L(0); PG8_BAR; PG8_MMA(1, 0, At, B0); PG8_MMA(1, 1, At, B1); PG8_BAR; PG8_SCHED;
            PG8_LDB(B0, 1, 0); PG8_LDB(B1, 1, 1); PG8_SCHED; PG8_LDA(At, 1, 0); PG8_STAGE(PG8_SA(0, 1), a2 + hstep, voffA);
            PG8_WAIT_V(8); PG8_WAIT_L(0); PG8_BAR; PG8_MMA(0, 0, At, B0); PG8_MMA(0, 1, At, B1); PG8_BAR; PG8_SCHED;
            PG8_LDA(At, 1, 1); PG8_STAGE(PG8_SB(1, 0), b3, voffB); PG8_STAGE(PG8_SB(1, 1), b3 + hstep, voffB); PG8_STAGE(PG8_SA(1, 0), a3, voffA);
            PG8_WAIT_V(8); PG8_WAIT_L(0); PG8_BAR; PG8_MMA(1, 0, At, B0); PG8_MMA(1, 1, At, B1); PG8_BAR; PG8_SCHED;
            } else {
            PG8_LDB(B0, 0, 0); PG8_SCHED; PG8_LDA(At, 0, 0); PG8_STAGE(PG8_SA(1, 1), a1 + hstep, voffA);
            PG8_WAIT_L(8); PG8_BAR; PG8_WAIT_L(0); PG8_MMA(0, 0, At, B0); PG8_BAR; PG8_SCHED;
            PG8_LDB(B1, 0, 1); PG8_STAGE(PG8_SB(0, 0), b2, voffB);
            PG8_BAR; PG8_WAIT_L(0); PG8_MMA(0, 1, At, B1); PG8_BAR;
            PG8_LDA(At, 0, 1); PG8_STAGE(PG8_SA(0, 0), a2, voffA);
            PG8_BAR; PG8_WAIT_L(0); PG8_MMA(1, 0, At, B0); PG8_BAR; PG8_SCHED;
            PG8_STAGE(PG8_SB(0, 1), b2 + hstep, voffB);
            PG8_WAIT_V(6); PG8_BAR; PG8_MMA(1, 1, At, B1); PG8_BAR;
            PG8_LDB(B0, 1, 0); PG8_SCHED; PG8_LDA(At, 1, 0); PG8_STAGE(PG8_SA(0, 1), a2 + hstep, voffA);
            PG8_WAIT_L(8); PG8_BAR; PG8_WAIT_L(0); PG8_MMA(0, 0, At, B0); PG8_BAR; PG8_SCHED;
            PG8_LDB(B1, 1, 1); PG8_STAGE(PG8_SB(1, 0), b3, voffB);
            PG8_BAR; PG8_WAIT_L(0); PG8_MMA(0, 1, At, B1); PG8_BAR;
            PG8_LDA(At, 1, 1); PG8_STAGE(PG8_SA(1, 0), a3, voffA);
            PG8_BAR; PG8_WAIT_L(0); PG8_MMA(1, 0, At, B0); PG8_BAR; PG8_SCHED;
            PG8_STAGE(PG8_SB(1, 1), b3 + hstep, voffB);
            PG8_WAIT_V(6); PG8_BAR; PG8_MMA(1, 1, At, B1); PG8_BAR;
            }
        }
        if constexpr (ALIGN_EPI) { if (wr == 0) PG8_BAR; }
        if constexpr (!Epi::AFTER_DRAIN) { E(acc, cur, wr, wc, fr, fq); S.done(cur); }
        if (!has_next) break;
#pragma unroll
        for (int a = 0; a < 2; ++a)
#pragma unroll
            for (int b = 0; b < 2; ++b)
#pragma unroll
                for (int m = 0; m < 4; ++m)
#pragma unroll
                    for (int n = 0; n < 2; ++n) acc[a][b][m][n] = (f32x4){0.f, 0.f, 0.f, 0.f};
        cur = nxt; cA = nA; cB = nB; ++ui;
        if constexpr (ALIGN_EPI) { if (wr == 1) PG8_BAR; }
    }
    PG8_WAIT_V(0);
    if constexpr (!ALIGN_EPI) { if (wr == 0) PG8_BAR; }
    PG8_BAR;
    if constexpr (Epi::AFTER_DRAIN) { E.fused(acc, cur, wr, wc, fr, fq, lds, wid, lane); S.done(cur); }
#undef PG8_SA
#undef PG8_SB
#undef PG8_STAGE
#undef PG8_LDA
#undef PG8_LDB
#undef PG8_MMA
#undef PG8_WAIT_V
#undef PG8_WAIT_L
#undef PG8_BAR
#undef PG8_SCHED
}
}

#define LAS __attribute__((address_space(3)))
typedef _Float16 h16;
typedef h16 h16x2 __attribute__((ext_vector_type(2)));
typedef h16 h16x4 __attribute__((ext_vector_type(4)));
typedef h16 h16x8 __attribute__((ext_vector_type(8)));
typedef float f32x4 __attribute__((ext_vector_type(4)));
typedef float f32x16 __attribute__((ext_vector_type(16)));
typedef unsigned u32x4 __attribute__((ext_vector_type(4)));
typedef unsigned u32x2 __attribute__((ext_vector_type(2)));

constexpr int TP = 65536, TS = 16384, TT = TP + TS, DM = 1024, N0 = 3328, N1 = 4096;
constexpr float EPS = 1e-6f;
constexpr float QSCALE = 0.125f * 1.4426950408889634f;
constexpr size_t MiB = 1u << 20;
constexpr size_t WS_CTL = 0, WS_BAR = 4096;
constexpr size_t WS_TAXC = 1 * MiB, WS_TAXS = 1 * MiB + 8192, WS_TPRC = 1 * MiB + 65536, WS_TPRS = 1 * MiB + 65536 + 131072;
constexpr size_t WS_SSQ0 = 2 * MiB, WS_SSQ1 = 2 * MiB + 512 * 1024;
constexpr size_t WS_WIN0 = 3 * MiB, WS_WOUT0 = 10 * MiB, WS_WIN1 = 12 * MiB, WS_WOUT1 = 20 * MiB;
constexpr size_t WS_XH = 24 * MiB, WS_MIX = 184 * MiB, WS_Z = 344 * MiB, WS_STASH = 984 * MiB, WS_END = 1008 * MiB;
constexpr int LDS_BYTES = 163840;
constexpr int NTHREADS = 512;

struct Params {
    const float* in[19];
    float* out;
    unsigned char* ws;
    int ph_lo, ph_hi;
    double frq[24];
};

__device__ __forceinline__ float wave_sum(float v) {
#pragma unroll
    for (int o = 32; o; o >>= 1) v += __shfl_xor(v, o);
    return v;
}
__device__ __forceinline__ int opaque_lane() { int l; asm volatile("v_mbcnt_lo_u32_b32 %0, -1, 0\n\tv_mbcnt_hi_u32_b32 %0, -1, %0" : "=v"(l)); return l; }
__device__ __forceinline__ float max3f(float a, float b, float c) { float r; asm("v_max3_f32 %0, %1, %2, %3" : "=v"(r) : "v"(a), "v"(b), "v"(c)); return r; }
__device__ __forceinline__ float max2f(float a, float b) { float r; asm("v_max_f32_e32 %0, %1, %2" : "=v"(r) : "v"(a), "v"(b)); return r; }
__device__ __forceinline__ float swapmax32(float v) {
    auto rr = __builtin_amdgcn_permlane32_swap(__float_as_uint(v), __float_as_uint(v), false, false);
    return max2f(__uint_as_float(rr[0]), __uint_as_float(rr[1]));
}
__device__ __forceinline__ float swapsum32(float v) {
    auto rr = __builtin_amdgcn_permlane32_swap(__float_as_uint(v), __float_as_uint(v), false, false);
    return __uint_as_float(rr[0]) + __uint_as_float(rr[1]);
}
__device__ __forceinline__ unsigned zo(int slot, int row) { return ((unsigned)slot * (unsigned)TT + (unsigned)row) * 64u; }
__device__ __forceinline__ float fexp2(float x) { return __builtin_amdgcn_exp2f(x); }
__device__ __forceinline__ unsigned pk2(float a, float b) { h16x2 v = {(h16)a, (h16)b}; return __builtin_bit_cast(unsigned, v); }
__device__ __forceinline__ h16x4 tr16(LAS const unsigned char* p) {
    typedef short v4i16_t __attribute__((ext_vector_type(4)));
    return __builtin_bit_cast(h16x4, __builtin_amdgcn_ds_read_tr16_b64_v4i16((LAS v4i16_t*)p));
}
__device__ __forceinline__ f32x16 mfma32(h16x8 a, h16x8 b, f32x16 c) { return __builtin_amdgcn_mfma_f32_32x32x16_f16(a, b, c, 0, 0, 0); }

__device__ __forceinline__ void p0_phase(const Params& P, LAS unsigned char* lds, int tid_in) {
    int tid_ = tid_in; asm volatile("" : "+v"(tid_));
    const int tid = tid_, lane = tid & 63, wave = tid >> 6, bid = blockIdx.x, nb = gridDim.x;
    unsigned char* ws = P.ws;
    LAS h16* ts = (LAS h16*)lds;
    for (int tile = bid; tile < 2368; tile += nb) {
        const int ntile = tile >> 4, kt = tile & 15;
        const float* w; const float* g; h16* wt; int N, nt, perm;
        if (ntile < 52)       { w = P.in[3];  g = P.in[2];  wt = (h16*)(ws + WS_WIN0);  N = N0;   nt = ntile;       perm = 1; }
        else if (ntile < 68)  { w = P.in[4];  g = nullptr;  wt = (h16*)(ws + WS_WOUT0); N = 1024; nt = ntile - 52;  perm = 0; }
        else if (ntile < 132) { w = P.in[15]; g = P.in[14]; wt = (h16*)(ws + WS_WIN1);  N = N1;   nt = ntile - 68;  perm = 1; }
        else                  { w = P.in[16]; g = nullptr;  wt = (h16*)(ws + WS_WOUT1); N = 1024; nt = ntile - 132; perm = 0; }
        const int k0 = kt * 64, n0 = nt * 64;
#pragma unroll
        for (int i = 0; i < 8; ++i) {
            const int kk = wave + 8 * i;
            float v = w[(size_t)(k0 + kk) * N + n0 + lane];
            if (g) v *= g[k0 + kk];
            ts[kk * 66 + lane] = (h16)v;
        }
        __syncthreads();
#pragma unroll
        for (int i = 0; i < 8; ++i) {
            const int nn = wave + 8 * i;
            const int c = n0 + nn;
            int pr = c;
            if (perm) { const int t256 = c >> 8, lc = c & 255, hh = lc >> 6, d = lc & 63; pr = (t256 << 8) + 128 * (d >> 5) + 32 * hh + (d & 31); }
            wt[(size_t)pr * 1024 + k0 + lane] = ts[lane * 66 + nn];
        }
        __syncthreads();
    }
    h16* XH = (h16*)(ws + WS_XH);
    float* ssq0 = (float*)(ws + WS_SSQ0);
    float* ssq1 = (float*)(ws + WS_SSQ1);
    for (int row0 = bid * 8 + wave; row0 < TT; row0 += nb * 32) {
        f32x4 v[4][4];
#pragma unroll
        for (int t = 0; t < 4; ++t) {
            const int row = row0 + t * nb * 8;
            if (row < TT) {
                const float* src = row < TP ? P.in[0] + (size_t)row * 1024 : P.in[1] + (size_t)(row - TP) * 1024;
#pragma unroll
                for (int i = 0; i < 4; ++i) v[t][i] = __builtin_nontemporal_load((const f32x4*)(src + i * 256 + lane * 4));
            }
        }
#pragma unroll
        for (int t = 0; t < 4; ++t) {
            const int row = row0 + t * nb * 8;
            if (row < TT) {
                h16* dst = XH + (size_t)row * 1024;
                float ss = 0.f;
#pragma unroll
                for (int i = 0; i < 4; ++i) {
                    ss += v[t][i][0] * v[t][i][0] + v[t][i][1] * v[t][i][1] + v[t][i][2] * v[t][i][2] + v[t][i][3] * v[t][i][3];
                    u32x2 pk; pk[0] = pk2(v[t][i][0], v[t][i][1]); pk[1] = pk2(v[t][i][2], v[t][i][3]);
                    *(u32x2*)(dst + i * 256 + lane * 4) = pk;
                }
                ss = wave_sum(ss);
                if (lane == 0) ssq0[row] = ss;
            }
        }
    }
    const int gtid = bid * NTHREADS + tid, gn = nb * NTHREADS;
    for (int i = gtid; i < TT; i += gn) ssq1[i] = 0.f;
    if (bid == 0 && wave == 0) {
        float a = P.in[9][lane] * P.in[10][lane], b = P.in[11][lane] * P.in[12][lane];
        a = wave_sum(a); b = wave_sum(b);
        if (lane == 0) ((float*)(ws + WS_CTL))[0] = __expf(a) - __expf(b) + 0.2f;
    }
}

__device__ __forceinline__ float partner16(float x) {
    auto r = __builtin_amdgcn_permlane16_swap(__float_as_uint(x), __float_as_uint(x), false, false);
    return __uint_as_float(r[0] == __float_as_uint(x) ? r[1] : r[0]);
}
__device__ __forceinline__ float partner32(float x) {
    auto r = __builtin_amdgcn_permlane32_swap(__float_as_uint(x), __float_as_uint(x), false, false);
    return __uint_as_float(r[0] == __float_as_uint(x) ? r[1] : r[0]);
}
__device__ __forceinline__ float sum16(float x) { auto r = __builtin_amdgcn_permlane16_swap(__float_as_uint(x), __float_as_uint(x), false, false); return __uint_as_float(r[0]) + __uint_as_float(r[1]); }
__device__ __forceinline__ float sum32(float x) { auto r = __builtin_amdgcn_permlane32_swap(__float_as_uint(x), __float_as_uint(x), false, false); return __uint_as_float(r[0]) + __uint_as_float(r[1]); }

struct EpiIn {
    static constexpr bool PERM = true, AFTER_DRAIN = false;
    h16* Z; int ldz; int layer; const float* ssq;
    const float* g0; const float* g1; const float* g2; const float* g3;
    __device__ __forceinline__ void operator()(const pg8::f32x4 (&acc)[2][2][4][2], const pg8::Unit& u, int wr, int wc, int fr, int fq) const {
        const int gh = u.pn * 4 + wc;
        int type; const float* gain = g0; float qs = 1.f;
        if (layer == 0) {
            if (gh < 8) { type = 2; gain = g0; qs = QSCALE; }
            else if (gh < 10) { type = 2; gain = g1; }
            else if (gh < 12) { type = 0; }
            else if (gh < 20) { type = 1; gain = g2; qs = QSCALE; }
            else if (gh < 28) { type = 1; gain = g3; }
            else if (gh < 36) { type = 0; }
            else { type = 3; }
        } else {
            if (gh < 16) { type = 1; gain = g2; qs = QSCALE; }
            else if (gh < 32) { type = 1; gain = g3; }
            else if (gh < 48) { type = 0; }
            else { type = 3; }
        }
        type = __builtin_amdgcn_readfirstlane(type);
        constexpr float PRF[8] = {1.591549431e-01f, 3.086376340e-02f, 5.985185713e-03f, 1.160663641e-03f, 2.250790790e-04f, 4.364795279e-05f, 8.464330808e-06f, 1.641426263e-06f};
        constexpr float AXF[16] = {1.591549431e-01f, 8.949940161e-02f, 5.032921210e-02f, 2.830219583e-02f, 1.591549431e-02f, 8.949940161e-03f, 5.032921210e-03f, 2.830219583e-03f,
                                   1.591549431e-03f, 8.949940161e-04f, 5.032921210e-04f, 2.830219583e-04f, 1.591549431e-04f, 8.949940161e-05f, 5.032921210e-05f, 2.830219583e-05f};
        float gv[2][8], frev[8];
#pragma unroll
        for (int e = 0; e < 8; ++e) frev[e] = type == 1 ? PRF[e] : ((fq & 1) ? AXF[8 + e] : AXF[e]);
#pragma unroll
        for (int bj = 0; bj < 2; ++bj)
#pragma unroll
            for (int e = 0; e < 8; ++e) gv[bj][e] = (type == 1 || type == 2) ? gain[32 * bj + 8 * fq + e] * qs : 1.f;
        h16* zcol = Z + 8 * fq;
        float rsv[2][4];
#pragma unroll
        for (int ai = 0; ai < 2; ++ai)
#pragma unroll
            for (int m = 0; m < 4; ++m) rsv[ai][m] = ssq[u.pm * 256 + ai * 128 + wr * 64 + m * 16 + fr];
#pragma unroll
        for (int ai = 0; ai < 2; ++ai)
#pragma unroll
            for (int m = 0; m < 4; ++m) {
                const int row = u.pm * 256 + ai * 128 + wr * 64 + m * 16 + fr;
                const float rs = __builtin_amdgcn_rsqf(rsv[ai][m] * (1.f / 1024.f) + EPS);
                float v[2][8];
#pragma unroll
                for (int bj = 0; bj < 2; ++bj)
#pragma unroll
                    for (int n = 0; n < 2; ++n)
#pragma unroll
                        for (int e = 0; e < 4; ++e) v[bj][4 * n + e] = acc[ai][bj][m][n][e] * rs;
                if (type == 1 || type == 2) {
                    float ss = 0.f;
#pragma unroll
                    for (int bj = 0; bj < 2; ++bj)
#pragma unroll
                        for (int e = 0; e < 8; ++e) ss += v[bj][e] * v[bj][e];
                    ss = sum32(sum16(ss));
                    const float rn = __builtin_amdgcn_rsqf(ss * (1.f / 64.f) + EPS);
#pragma unroll
                    for (int bj = 0; bj < 2; ++bj)
#pragma unroll
                        for (int e = 0; e < 8; ++e) v[bj][e] *= rn * gv[bj][e];
                    const int s = row < TP ? (row & 2047) : (row & 4095);
                    if (type == 1) {
                        const float pos = (float)s;
                        const float sg = fq == 0 ? -1.f : 1.f;
#pragma unroll
                        for (int e = 0; e < 8; ++e) {
                            const float pr = partner16(v[0][e]);
                            const float ang = __builtin_amdgcn_fractf(pos * frev[e]);
                            const float cs = __builtin_amdgcn_cosf(ang), sn = __builtin_amdgcn_sinf(ang);
                            const float rv = v[0][e] * cs + sg * pr * sn;
                            v[0][e] = fq < 2 ? rv : v[0][e];
                        }
                    } else {
                        const float sg = fq < 2 ? -1.f : 1.f;
#pragma unroll
                        for (int bj = 0; bj < 2; ++bj) {
                            const float pos = (float)(bj == 0 ? (s >> 6) : (s & 63));
#pragma unroll
                            for (int e = 0; e < 8; ++e) {
                                const float pr = partner32(v[bj][e]);
                                const float ang = __builtin_amdgcn_fractf(pos * frev[e]);
                                const float cs = __builtin_amdgcn_cosf(ang), sn = __builtin_amdgcn_sinf(ang);
                                v[bj][e] = v[bj][e] * cs + sg * pr * sn;
                            }
                        }
                    }
                } else if (type == 3) {
#pragma unroll
                    for (int bj = 0; bj < 2; ++bj)
#pragma unroll
                        for (int e = 0; e < 8; ++e) { const float x = v[bj][e]; v[bj][e] = x * __builtin_amdgcn_rcpf(1.f + fexp2(-1.4426950408889634f * x)); }
                }
                h16* rowp = zcol + zo(gh, row);
#pragma unroll
                for (int bj = 0; bj < 2; ++bj) {
                    u32x4 w; w[0] = pk2(v[bj][0], v[bj][1]); w[1] = pk2(v[bj][2], v[bj][3]); w[2] = pk2(v[bj][4], v[bj][5]); w[3] = pk2(v[bj][6], v[bj][7]);
                    *(u32x4*)(rowp + 32 * bj) = w;
                }
            }
    }
};

struct EpiOut0 {
    static constexpr bool PERM = true, AFTER_DRAIN = false;
    const float* xp; const float* xs; h16* X1; float* ssq1;
    __device__ __forceinline__ void operator()(const pg8::f32x4 (&acc)[2][2][4][2], const pg8::Unit& u, int wr, int wc, int fr, int fq) const {
        const int col0 = u.pn * 256 + wc * 32 + 8 * fq;
#pragma unroll
        for (int ai = 0; ai < 2; ++ai)
#pragma unroll
            for (int m = 0; m < 4; ++m) {
                const int row = u.pm * 256 + ai * 128 + wr * 64 + m * 16 + fr;
                const float* xr = row < TP ? xp + (size_t)row * 1024 : xs + (size_t)(row - TP) * 1024;
                float ss = 0.f;
#pragma unroll
                for (int bj = 0; bj < 2; ++bj) {
                    const int c = col0 + 128 * bj;
                    const f32x4 a0 = __builtin_nontemporal_load((const f32x4*)(xr + c)) + acc[ai][bj][m][0];
                    const f32x4 a1 = __builtin_nontemporal_load((const f32x4*)(xr + c + 4)) + acc[ai][bj][m][1];
                    ss += a0[0] * a0[0] + a0[1] * a0[1] + a0[2] * a0[2] + a0[3] * a0[3] + a1[0] * a1[0] + a1[1] * a1[1] + a1[2] * a1[2] + a1[3] * a1[3];
                    u32x4 w; w[0] = pk2(a0[0], a0[1]); w[1] = pk2(a0[2], a0[3]); w[2] = pk2(a1[0], a1[1]); w[3] = pk2(a1[2], a1[3]);
                    *(u32x4*)(X1 + (size_t)row * 1024 + c) = w;
                }
                ss += __shfl_xor(ss, 16); ss += __shfl_xor(ss, 32);
                if (fq == 0) atomicAdd(ssq1 + row, ss);
            }
    }
};

struct EpiOut1 {
    static constexpr bool PERM = true, AFTER_DRAIN = false;
    const h16* X1; float* out;
    __device__ __forceinline__ void operator()(const pg8::f32x4 (&acc)[2][2][4][2], const pg8::Unit& u, int wr, int wc, int fr, int fq) const {
        const int col0 = u.pn * 256 + wc * 32 + 8 * fq;
#pragma unroll
        for (int ai = 0; ai < 2; ++ai)
#pragma unroll
            for (int m = 0; m < 4; ++m) {
                const int row = u.pm * 256 + ai * 128 + wr * 64 + m * 16 + fr;
#pragma unroll
                for (int bj = 0; bj < 2; ++bj) {
                    const int c = col0 + 128 * bj;
                    const h16x8 xv = *(const h16x8*)(X1 + (size_t)row * 1024 + c);
                    f32x4 a0 = acc[ai][bj][m][0], a1 = acc[ai][bj][m][1];
#pragma unroll
                    for (int e = 0; e < 4; ++e) { a0[e] += (float)xv[e]; a1[e] += (float)xv[4 + e]; }
                    __builtin_nontemporal_store(a0, (f32x4*)(out + (size_t)row * 1024 + c));
                    __builtin_nontemporal_store(a1, (f32x4*)(out + (size_t)row * 1024 + c + 4));
                }
            }
    }
};

template <int DV, int EXP>
__device__ __forceinline__ void dense_tile(LAS const unsigned char* Kb, LAS const unsigned char* Vb, const h16x8 (&qf)[4], f32x16 (&o)[DV / 32], float& m, float& l, int lane) {
    constexpr int VP = (DV == 64) ? 192 : 320;
    const int r = lane & 31, h = lane >> 5;
    f32x16 st0, st1;
    const float base = m > -1e29f ? m : 0.f;
#pragma unroll
    for (int i = 0; i < 16; ++i) { st0[i] = -base; st1[i] = -base; }
    LAS const unsigned char* kp = Kb + r * 144 + h * 16;
#pragma unroll
    for (int ks = 0; ks < 4; ++ks) {
        const h16x8 a0 = *(LAS const h16x8*)(kp + ks * 32);
        const h16x8 a1 = *(LAS const h16x8*)(kp + 32 * 144 + ks * 32);
        st0 = mfma32(a0, qf[ks], st0);
        st1 = mfma32(a1, qf[ks], st1);
    }
#ifdef MK_SCHED_FENCE
    __builtin_amdgcn_sched_barrier(0);
#endif
    if (EXP != 1) {
        float ta = max3f(st0[0], st0[1], st1[0]), tb = max3f(st0[2], st0[3], st1[1]);
        ta = max3f(ta, st1[2], st1[3]);
#pragma unroll
        for (int i = 4; i < 16; i += 4) { ta = max3f(ta, st0[i], st0[i + 1]); tb = max3f(tb, st0[i + 2], st0[i + 3]); ta = max3f(ta, st1[i], st1[i + 1]); tb = max3f(tb, st1[i + 2], st1[i + 3]); }
        const float tm = swapmax32(max2f(ta, tb));
        const float mrel = m - base;
        const float mn = max2f(tm, mrel);
        m = base + mn;
        float rs = 0.f;
        const float alpha = fexp2(mrel - mn);
#pragma unroll
        for (int i = 0; i < 16; ++i) { st0[i] = fexp2(st0[i] - mn); st1[i] = fexp2(st1[i] - mn); rs += st0[i] + st1[i]; }
        l = l * alpha + rs;
        if (__builtin_amdgcn_ballot_w64(mn != 0.f) != 0) {
#pragma unroll
            for (int db = 0; db < DV / 32; ++db)
#pragma unroll
                for (int i = 0; i < 16; ++i) o[db][i] *= alpha;
        }
    } else { l += 1.f; }
    h16x8 pf[4];
#pragma unroll
    for (int j = 0; j < 8; ++j) { pf[0][j] = (h16)st0[j]; pf[1][j] = (h16)st0[8 + j]; pf[2][j] = (h16)st1[j]; pf[3][j] = (h16)st1[8 + j]; }
    if (EXP == 3) { o[0][0] += (float)pf[0][0] + (float)pf[1][1] + (float)pf[2][2] + (float)pf[3][3]; return; }
    const int i16 = r & 15, q = i16 >> 2, p = i16 & 3, ch = r >> 4;
    LAS const unsigned char* vp = Vb + (4 * h + q) * VP + (16 * ch + 4 * p) * 2;
#ifdef MK_SCHED_FENCE
    __builtin_amdgcn_sched_barrier(0);
#endif
#pragma unroll
    for (int db = 0; db < DV / 32; ++db)
#pragma unroll
        for (int kk = 0; kk < 4; ++kk) {
            const h16x4 lo = tr16(vp + (16 * kk) * VP + db * 64);
            const h16x4 hi = tr16(vp + (16 * kk + 8) * VP + db * 64);
            const h16x8 vf = {lo[0], lo[1], lo[2], lo[3], hi[0], hi[1], hi[2], hi[3]};
            o[db] = mfma32(vf, pf[kk], o[db]);
            if (DV == 128 && kk == 3) __builtin_amdgcn_sched_barrier(0);
        }
}

template <int EXP>
__device__ __forceinline__ void dense_tile_h(LAS const unsigned char* Kb, LAS const unsigned char* Vb, const h16x8 (&qf)[4], f32x16 (&o)[4], float& m, float& l, int lane) {
    constexpr int VP = 320;
    const int r = lane & 31, h = lane >> 5;
    const int i16 = r & 15, q = i16 >> 2, p = i16 & 3, ch = r >> 4;
    LAS const unsigned char* vp = Vb + (4 * h + q) * VP + (16 * ch + 4 * p) * 2;
    LAS const unsigned char* kp = Kb + r * 144 + h * 16;
    const float base = m > -1e29f ? m : 0.f;
    f32x16 sth[2];
#pragma unroll
    for (int kbh = 0; kbh < 2; ++kbh) {
#pragma unroll
        for (int i = 0; i < 16; ++i) sth[kbh][i] = -base;
#pragma unroll
        for (int ks = 0; ks < 4; ++ks) sth[kbh] = mfma32(*(LAS const h16x8*)(kp + kbh * 32 * 144 + ks * 32), qf[ks], sth[kbh]);
    }
#pragma unroll
    for (int kbh = 0; kbh < 2; ++kbh) {
        f32x16& st = sth[kbh];
        float tm = max3f(st[0], st[1], st[2]);
#pragma unroll
        for (int i = 3; i < 15; i += 2) tm = max3f(tm, st[i], st[i + 1]);
        tm = swapmax32(max2f(tm, st[15]));
        const float mrel = m - base;
        const float mn = max2f(tm, mrel);
        m = base + mn;
        const float alpha = fexp2(mrel - mn);
        float rs = 0.f;
#pragma unroll
        for (int i = 0; i < 16; ++i) { st[i] = fexp2(st[i] - mn); rs += st[i]; }
        l = l * alpha + rs;
        if (__builtin_amdgcn_ballot_w64(alpha != 1.f) != 0) {
#pragma unroll
            for (int db = 0; db < 4; ++db)
#pragma unroll
                for (int i = 0; i < 16; ++i) o[db][i] *= alpha;
        }
        h16x8 pf[2];
#pragma unroll
        for (int j = 0; j < 8; ++j) { pf[0][j] = (h16)st[j]; pf[1][j] = (h16)st[8 + j]; }
#pragma unroll
        for (int db = 0; db < 4; ++db)
#pragma unroll
            for (int s2 = 0; s2 < 2; ++s2) {
                const int kk = 2 * kbh + s2;
                const h16x4 lo = tr16(vp + (16 * kk) * VP + db * 64);
                const h16x4 hi = tr16(vp + (16 * kk + 8) * VP + db * 64);
                const h16x8 vf = {lo[0], lo[1], lo[2], lo[3], hi[0], hi[1], hi[2], hi[3]};
                o[db] = mfma32(vf, pf[s2], o[db]);
            }
    }
}

template <int DV, int NMAP, int EXP>
__device__ __forceinline__ void dense_unit(const h16* __restrict__ Z, h16* __restrict__ MIX, int tseq, int S, int qb, int qcol, int kcol, int vcol, int ocol, int gcol,
                                           float lam, const float* __restrict__ subln, LAS unsigned char* lds, int tid_in, float* dbg = nullptr) {
    constexpr int VP = (DV == 64) ? 192 : 320;
    constexpr int KBB = 64 * 144, VBB = 64 * VP, NV = DV / 64;
    int tid_ = tid_in * 64 + opaque_lane();
    const int tid = tid_, lane = tid & 63, wave = tid >> 6, r = lane & 31, h = lane >> 5;
    const int tq = tseq + qb * 256 + wave * 32 + r;
    const int NT = S >> 6;
    LAS h16x8* stl = (LAS h16x8*)(lds + 2 * KBB + 2 * VBB + wave * 8192) + lane;
    const int kkey = tid >> 3, kch = tid & 7;
    const int vkey = (DV == 64) ? (tid >> 3) : (tid >> 4), vch = (DV == 64) ? (tid & 7) : (tid & 15);
#pragma unroll 1
    for (int mp = 0; mp < NMAP; ++mp) {
        h16x8 qf[4];
        {
            const unsigned qoff = zo((qcol >> 6) + mp, tq) + 8 * h;
#pragma unroll
            for (int ks = 0; ks < 4; ++ks) qf[ks] = *(const h16x8*)(Z + (qoff + 16 * ks));
        }
        f32x16 o[DV / 32];
#pragma unroll
        for (int db = 0; db < DV / 32; ++db)
#pragma unroll
            for (int i = 0; i < 16; ++i) o[db][i] = 0.f;
        float m = -1e30f, l = 0.f;
        const unsigned koff = zo((kcol >> 6) + mp, tseq + kkey) + kch * 8;
        const unsigned voff = zo((vcol >> 6) + (vch >> 3), tseq + vkey) + (vch & 7) * 8;
        u32x4 kr, vr[NV];
        kr = *(const u32x4*)(Z + koff);
#pragma unroll
        for (int i = 0; i < NV; ++i) vr[i] = *(const u32x4*)(Z + (voff + (unsigned)(32 * i) * 64u));
        __syncthreads();
        *(LAS u32x4*)(lds + kkey * 144 + kch * 16) = kr;
#pragma unroll
        for (int i = 0; i < NV; ++i) *(LAS u32x4*)(lds + 2 * KBB + (vkey + 32 * i) * VP + vch * 16) = vr[i];
        __syncthreads();
        if (EXP == 0) {
            u32x4 kr2, vr2[NV];
            asm volatile("" ::: "memory");
            kr = *(const u32x4*)(Z + (koff + 64u * 64u));
#pragma unroll
            for (int i = 0; i < NV; ++i) vr[i] = *(const u32x4*)(Z + (voff + (unsigned)(64 + 32 * i) * 64u));
#pragma unroll 1
            for (int j = 0; j < NT; j += 2) {
                if (j + 2 < NT) {
                    kr2 = *(const u32x4*)(Z + (koff + (unsigned)(64 * (j + 2)) * 64u));
#pragma unroll
                    for (int i = 0; i < NV; ++i) vr2[i] = *(const u32x4*)(Z + (voff + (unsigned)(64 * (j + 2) + 32 * i) * 64u));
                }
                if constexpr (DV == 128) dense_tile_h<EXP>(lds, lds + 2 * KBB, qf, o, m, l, lane); else dense_tile<DV, EXP>(lds, lds + 2 * KBB, qf, o, m, l, lane);
                *(LAS u32x4*)(lds + KBB + kkey * 144 + kch * 16) = kr;
#pragma unroll
                for (int i = 0; i < NV; ++i) *(LAS u32x4*)(lds + 2 * KBB + VBB + (vkey + 32 * i) * VP + vch * 16) = vr[i];
                __syncthreads();
                if (j + 3 < NT) {
                    kr = *(const u32x4*)(Z + (koff + (unsigned)(64 * (j + 3)) * 64u));
#pragma unroll
                    for (int i = 0; i < NV; ++i) vr[i] = *(const u32x4*)(Z + (voff + (unsigned)(64 * (j + 3) + 32 * i) * 64u));
                }
                if constexpr (DV == 128) dense_tile_h<EXP>(lds + KBB, lds + 2 * KBB + VBB, qf, o, m, l, lane); else dense_tile<DV, EXP>(lds + KBB, lds + 2 * KBB + VBB, qf, o, m, l, lane);
                if (j + 2 < NT) {
                    *(LAS u32x4*)(lds + kkey * 144 + kch * 16) = kr2;
#pragma unroll
                    for (int i = 0; i < NV; ++i) *(LAS u32x4*)(lds + 2 * KBB + (vkey + 32 * i) * VP + vch * 16) = vr2[i];
                }
                __syncthreads();
            }
        } else {
#pragma unroll 1
        for (int j = 0; j < NT; ++j) {
            const int cur = j & 1;
            if (EXP != 2 && j + 1 < NT) {
                kr = *(const u32x4*)(Z + (koff + (unsigned)(64 * (j + 1)) * 64u));
#pragma unroll
                for (int i = 0; i < NV; ++i) vr[i] = *(const u32x4*)(Z + (voff + (unsigned)(64 * (j + 1) + 32 * i) * 64u));
            }
            dense_tile<DV, EXP>(lds + cur * KBB, lds + 2 * KBB + cur * VBB, qf, o, m, l, lane);
            if (EXP != 2 && j + 1 < NT) {
                *(LAS u32x4*)(lds + (cur ^ 1) * KBB + kkey * 144 + kch * 16) = kr;
#pragma unroll
                for (int i = 0; i < NV; ++i) *(LAS u32x4*)(lds + 2 * KBB + (cur ^ 1) * VBB + (vkey + 32 * i) * VP + vch * 16) = vr[i];
            }
            __syncthreads();
        }
        }
        const float lt = swapsum32(l);
        const float inv = 1.f / lt;
        int he = h; asm volatile("" : "+v"(he));
        int tqe = tq; asm volatile("" : "+v"(tqe));
        const float* sl2 = subln; asm volatile("" : "+s"(sl2));
#ifdef DBG
        if (NMAP == 2 && dbg) {
#pragma unroll
            for (int db = 0; db < DV / 32; ++db)
#pragma unroll
                for (int g4 = 0; g4 < 4; ++g4) {
                    const int d0 = 32 * db + 8 * g4 + 4 * he;
                    f32x4 v; v[0] = o[db][4 * g4] * inv; v[1] = o[db][4 * g4 + 1] * inv; v[2] = o[db][4 * g4 + 2] * inv; v[3] = o[db][4 * g4 + 3] * inv;
                    *(f32x4*)(dbg + ((unsigned)tqe * 1024 + mp * 512 + (ocol - 512) + d0)) = v;
                }
        }
#endif
        if (NMAP == 2 && mp == 0) {
#pragma unroll
            for (int db = 0; db < DV / 32; ++db)
#pragma unroll
                for (int c = 0; c < 2; ++c) {
                    h16x8 hv;
#pragma unroll
                    for (int jj = 0; jj < 8; ++jj) hv[jj] = (h16)(o[db][8 * c + jj] * inv);
                    stl[(db * 2 + c) * 64] = hv;
                }
        } else if (NMAP == 1) {
#pragma unroll
            for (int db = 0; db < DV / 32; ++db)
#pragma unroll
                for (int g4 = 0; g4 < 4; ++g4) {
                    const int d0 = 32 * db + 8 * g4 + 4 * he;
                    const h16x4 gt = *(const h16x4*)(Z + (zo((gcol >> 6) + (db >> 1), tqe) + (d0 & 63)));
                    u32x2 w;
                    w[0] = pk2(o[db][4 * g4 + 0] * inv * (float)gt[0], o[db][4 * g4 + 1] * inv * (float)gt[1]);
                    w[1] = pk2(o[db][4 * g4 + 2] * inv * (float)gt[2], o[db][4 * g4 + 3] * inv * (float)gt[3]);
                    *(u32x2*)(MIX + (unsigned)tqe * 1024 + ocol + d0) = w;
                }
        } else {
            float ss = 0.f;
#pragma unroll
            for (int db = 0; db < DV / 32; ++db)
#pragma unroll
                for (int c = 0; c < 2; ++c) {
                    const h16x8 hv = stl[(db * 2 + c) * 64];
#pragma unroll
                    for (int jj = 0; jj < 8; ++jj) {
                        const float a = (float)hv[jj] - lam * (o[db][8 * c + jj] * inv);
                        o[db][8 * c + jj] = a;
                        ss += a * a;
                    }
                }
            ss += __shfl_xor(ss, 32);
            const float rn = __builtin_amdgcn_rsqf(ss * (1.f / (float)DV) + EPS) * 0.8f;
#pragma unroll
            for (int db = 0; db < DV / 32; ++db)
#pragma unroll
                for (int g4 = 0; g4 < 4; ++g4) {
                    const int d0 = 32 * db + 8 * g4 + 4 * he;
                    const h16x4 gt = *(const h16x4*)(Z + (zo((gcol >> 6) + (db >> 1), tqe) + (d0 & 63)));
                    const f32x4 sg = *(const f32x4*)(sl2 + d0);
                    u32x2 w;
                    w[0] = pk2(o[db][4 * g4 + 0] * rn * sg[0] * (float)gt[0], o[db][4 * g4 + 1] * rn * sg[1] * (float)gt[1]);
                    w[1] = pk2(o[db][4 * g4 + 2] * rn * sg[2] * (float)gt[2], o[db][4 * g4 + 3] * rn * sg[3] * (float)gt[3]);
                    *(u32x2*)(MIX + (unsigned)tqe * 1024 + ocol + d0) = w;
                    if (g4 == 1 || g4 == 3) asm volatile("" : "+v"(he), "+v"(tqe) : "v"(w[1]));
                }
        }
    }
}

__device__ __forceinline__ void a2_tile(LAS const unsigned char* Kb, LAS const unsigned char* Vb, const h16x8 (&qf)[2][4], f32x16 (&o)[2][2], float (&m)[2], float (&l)[2], int lane) {
    constexpr int VP = 192;
    const int r = lane & 31, h = lane >> 5;
    f32x16 st0[2], st1[2]; float base[2];
#pragma unroll
    for (int q2 = 0; q2 < 2; ++q2) {
        base[q2] = m[q2] > -1e29f ? m[q2] : 0.f;
#pragma unroll
        for (int i = 0; i < 16; ++i) { st0[q2][i] = -base[q2]; st1[q2][i] = -base[q2]; }
    }
    LAS const unsigned char* kp = Kb + r * 144 + h * 16;
#pragma unroll
    for (int ks = 0; ks < 4; ++ks) {
        const h16x8 a0 = *(LAS const h16x8*)(kp + ks * 32);
        const h16x8 a1 = *(LAS const h16x8*)(kp + 32 * 144 + ks * 32);
#pragma unroll
        for (int q2 = 0; q2 < 2; ++q2) { st0[q2] = mfma32(a0, qf[q2][ks], st0[q2]); st1[q2] = mfma32(a1, qf[q2][ks], st1[q2]); }
    }
    h16x8 pf[2][4];
#pragma unroll
    for (int q2 = 0; q2 < 2; ++q2) {
        f32x16& s0 = st0[q2]; f32x16& s1 = st1[q2];
        float ta = max3f(s0[0], s0[1], s1[0]), tb = max3f(s0[2], s0[3], s1[1]);
        ta = max3f(ta, s1[2], s1[3]);
#pragma unroll
        for (int i = 4; i < 16; i += 4) { ta = max3f(ta, s0[i], s0[i + 1]); tb = max3f(tb, s0[i + 2], s0[i + 3]); ta = max3f(ta, s1[i], s1[i + 1]); tb = max3f(tb, s1[i + 2], s1[i + 3]); }
        const float tm = swapmax32(max2f(ta, tb));
        const float mrel = m[q2] - base[q2];
        const float mn = max2f(tm, mrel);
        m[q2] = base[q2] + mn;
        const float alpha = fexp2(mrel - mn);
        float rs = 0.f;
#pragma unroll
        for (int i = 0; i < 16; ++i) { s0[i] = fexp2(s0[i] - mn); s1[i] = fexp2(s1[i] - mn); rs += s0[i] + s1[i]; }
        l[q2] = l[q2] * alpha + rs;
        if (__builtin_amdgcn_ballot_w64(alpha != 1.f) != 0) {
#pragma unroll
            for (int db = 0; db < 2; ++db)
#pragma unroll
                for (int i = 0; i < 16; ++i) o[q2][db][i] *= alpha;
        }
#pragma unroll
        for (int j = 0; j < 8; ++j) { pf[q2][0][j] = (h16)s0[j]; pf[q2][1][j] = (h16)s0[8 + j]; pf[q2][2][j] = (h16)s1[j]; pf[q2][3][j] = (h16)s1[8 + j]; }
    }
    const int i16 = r & 15, q = i16 >> 2, p = i16 & 3, ch = r >> 4;
    LAS const unsigned char* vp = Vb + (4 * h + q) * VP + (16 * ch + 4 * p) * 2;
#pragma unroll
    for (int db = 0; db < 2; ++db)
#pragma unroll
        for (int kk = 0; kk < 4; ++kk) {
            const h16x4 lo = tr16(vp + (16 * kk) * VP + db * 64);
            const h16x4 hi = tr16(vp + (16 * kk + 8) * VP + db * 64);
            const h16x8 vf = {lo[0], lo[1], lo[2], lo[3], hi[0], hi[1], hi[2], hi[3]};
#pragma unroll
            for (int q2 = 0; q2 < 2; ++q2) o[q2][db] = mfma32(vf, pf[q2][kk], o[q2][db]);
        }
}

__device__ __forceinline__ void dense_unit_a2(const h16* __restrict__ Z, h16* __restrict__ MIX, int tseq, int S, int qb, int qslot, int kslot, int vslot, int ocol, int gslot,
                                              LAS unsigned char* lds, int wave_in) {
    constexpr int VP = 192, KBB = 64 * 144, VBB = 64 * VP;
    const int tid = wave_in * 64 + opaque_lane();
    const int lane = tid & 63, wave = tid >> 6, r = lane & 31, h = lane >> 5;
    const int tq0 = tseq + qb * 512 + wave * 64 + r;
    const int NT = S >> 6;
    const int kkey = tid >> 3, kch = tid & 7;
    h16x8 qf[2][4];
#pragma unroll
    for (int q2 = 0; q2 < 2; ++q2) {
        const unsigned qoff = zo(qslot, tq0 + 32 * q2) + 8 * h;
#pragma unroll
        for (int ks = 0; ks < 4; ++ks) qf[q2][ks] = *(const h16x8*)(Z + (qoff + 16 * ks));
    }
    f32x16 o[2][2]; float m[2], l[2];
#pragma unroll
    for (int q2 = 0; q2 < 2; ++q2) {
#pragma unroll
        for (int i = 0; i < 16; ++i) { o[q2][0][i] = 0.f; o[q2][1][i] = 0.f; }
        m[q2] = -1e30f; l[q2] = 0.f;
    }
    const unsigned koff = zo(kslot, tseq + kkey) + kch * 8;
    const unsigned voff = zo(vslot, tseq + kkey) + kch * 8;
    u32x4 kr, vr;
    kr = *(const u32x4*)(Z + koff); vr = *(const u32x4*)(Z + voff);
    __syncthreads();
    *(LAS u32x4*)(lds + kkey * 144 + kch * 16) = kr;
    *(LAS u32x4*)(lds + 2 * KBB + kkey * VP + kch * 16) = vr;
    __syncthreads();
#pragma unroll 1
    for (int j = 0; j < NT; ++j) {
        const int cur = j & 1;
        if (j + 1 < NT) { kr = *(const u32x4*)(Z + (koff + (unsigned)(64 * (j + 1)) * 64u)); vr = *(const u32x4*)(Z + (voff + (unsigned)(64 * (j + 1)) * 64u)); }
        a2_tile(lds + cur * KBB, lds + 2 * KBB + cur * VBB, qf, o, m, l, lane);
        if (j + 1 < NT) {
            *(LAS u32x4*)(lds + (cur ^ 1) * KBB + kkey * 144 + kch * 16) = kr;
            *(LAS u32x4*)(lds + 2 * KBB + (cur ^ 1) * VBB + kkey * VP + kch * 16) = vr;
        }
        __syncthreads();
    }
    int he = h, tqe = tq0; asm volatile("" : "+v"(he), "+v"(tqe));
#pragma unroll
    for (int q2 = 0; q2 < 2; ++q2) {
        const float lt = swapsum32(l[q2]);
        const float inv = 1.f / lt;
        const int tq = tqe + 32 * q2;
#pragma unroll
        for (int db = 0; db < 2; ++db)
#pragma unroll
            for (int g4 = 0; g4 < 4; ++g4) {
                const int d0 = 32 * db + 8 * g4 + 4 * he;
                const h16x4 gt = *(const h16x4*)(Z + (zo(gslot, tq) + d0));
                u32x2 w;
                w[0] = pk2(o[q2][db][4 * g4 + 0] * inv * (float)gt[0], o[q2][db][4 * g4 + 1] * inv * (float)gt[1]);
                w[1] = pk2(o[q2][db][4 * g4 + 2] * inv * (float)gt[2], o[q2][db][4 * g4 + 3] * inv * (float)gt[3]);
                *(u32x2*)(MIX + ((unsigned)tq * 1024u + ocol + d0)) = w;
            }
    }
}

template <int EXP>
__device__ __forceinline__ void dense_phase(const Params& P, LAS unsigned char* lds, int tid_in) {
    const h16* Z = (const h16*)(P.ws + WS_Z);
    h16* MIX = (h16*)(P.ws + WS_MIX);
    tid_in = __builtin_amdgcn_readfirstlane(tid_in >> 6);
    const float lam = ((const float*)(P.ws + WS_CTL))[0];
    const float* subln = P.in[13];
    for (int u0 = blockIdx.x; u0 < 2560; u0 += gridDim.x) {
        const int u = gridDim.x == 256 ? ((u0 & ~255) | ((u0 & 7) << 5) | ((u0 & 255) >> 3)) : u0;
#ifdef DENSE_ONLY_A
        if (false) {
#else
        if (u < 1280) {
#endif
            int tseq, S, hb, qb;
            if (u < 256) { const int b = u >> 6; hb = (u >> 4) & 3; qb = u & 15; tseq = TP + b * 4096; S = 4096; }
            else { const int v = u - 256; const int b = v >> 5; hb = (v >> 3) & 3; qb = v & 7; tseq = b * 2048; S = 2048; }
            dense_unit<128, 2, EXP>(Z, MIX, tseq, S, qb, 768 + hb * 128, 1280 + hb * 128, 1792 + hb * 128, 512 + hb * 128, 2304 + 512 + hb * 128, lam, subln, lds, tid_in,
#if defined(DBG) && DBG == 3
                               P.out
#else
                               nullptr
#endif
                               );
        } else {
#ifndef DENSE_ONLY_B
            int tseq, S, hq, qb;
            if (u < 1536) { const int v = u - 1280; const int b = v >> 6; hq = (v >> 3) & 7; qb = v & 7; tseq = TP + b * 4096; S = 4096; }
            else { const int v = u - 1536; const int b = v >> 5; hq = (v >> 2) & 7; qb = v & 3; tseq = b * 2048; S = 2048; }
            dense_unit_a2(Z, MIX, tseq, S, qb, hq, 8 + (hq >> 2), 10 + (hq >> 2), hq * 64, 36 + hq, lds, tid_in);
#endif
        }
    }
}

template <int NG>
__device__ __forceinline__ void banded_item(const h16* __restrict__ Z, h16* __restrict__ MIX, LAS unsigned char* ost, LAS float* mst, LAS float* lst, LAS unsigned char* vl, LAS unsigned char* kl, LAS const unsigned char* vp,
                                            int T0, int seqbase, int off0, int L, int dsh, int rc, int mblk0, int head, bool first, bool last, int lane) {
    const int r = lane & 31, h = lane >> 5;
    const int qslot = head, kslot = 16 + head, vslot = 32 + head, gslot = 48 + head;
    const int mq0 = (off0 >> dsh) + mblk0 * 32;
    int tl[NG]; h16x8 qf[NG][4]; f32x16 o[NG][2]; float m[NG], l[NG];
#pragma unroll
    for (int g = 0; g < NG; ++g) {
        tl[g] = ((mblk0 * 32 + 32 * g + r) << dsh) + rc;
        const h16* qrow = Z + (zo(qslot, T0 + tl[g]) + 8 * h);
#pragma unroll
        for (int ks = 0; ks < 4; ++ks) qf[g][ks] = *(const h16x8*)(qrow + 16 * ks);
    }
#pragma unroll
    for (int g = 0; g < NG; ++g) {
        if (first) {
#pragma unroll
            for (int i = 0; i < 16; ++i) { o[g][0][i] = 0.f; o[g][1][i] = 0.f; }
            m[g] = -1e30f; l[g] = 0.f;
        } else {
            m[g] = mst[tl[g]]; const float lt0 = lst[tl[g]]; l[g] = h == 0 ? lt0 : 0.f;
#pragma unroll
            for (int db = 0; db < 2; ++db)
#pragma unroll
                for (int g4 = 0; g4 < 4; ++g4) {
                    const h16x4 sv = *(LAS const h16x4*)(ost + tl[g] * 136 + (32 * db + 8 * g4 + 4 * h) * 2);
#pragma unroll
                    for (int e = 0; e < 4; ++e) o[g][db][4 * g4 + e] = (float)sv[e] * lt0;
                }
        }
    }
    int kb_lo = -2, kb_hi = 1 + NG;
    while (mq0 + 32 * kb_lo < 0) ++kb_lo;
    while (mq0 + 32 * kb_hi >= L) --kb_hi;
    u32x4 krn[4], vrn[4];
#define BLOAD(kb) do { \
        _Pragma("unroll") for (int i = 0; i < 4; ++i) { const int c = lane + 64 * i; \
            const unsigned ro = (unsigned)(seqbase + ((mq0 + 32 * (kb) + (c >> 3)) << dsh) + rc) * 64u + 8 * (c & 7); \
            krn[i] = *(const u32x4*)(Z + ((unsigned)kslot * (unsigned)TT * 64u + ro)); \
            vrn[i] = *(const u32x4*)(Z + ((unsigned)vslot * (unsigned)TT * 64u + ro)); } } while (0)
    BLOAD(kb_lo);
#pragma unroll 1
    for (int kb = kb_lo; kb <= kb_hi; ++kb) {
#pragma unroll
        for (int i = 0; i < 4; ++i) { const int c = lane + 64 * i; *(LAS u32x4*)(vl + (c >> 3) * 192 + (c & 7) * 16) = vrn[i]; *(LAS u32x4*)(kl + (c >> 3) * 144 + (c & 7) * 16) = krn[i]; }
        asm volatile("s_waitcnt lgkmcnt(0)" ::: "memory");
        if (kb < kb_hi) BLOAD(kb + 1);
        h16x8 kf[4];
#pragma unroll
        for (int ks = 0; ks < 4; ++ks) kf[ks] = *(LAS const h16x8*)(kl + r * 144 + h * 16 + ks * 32);
        h16x8 pfg[NG][2];
#pragma unroll
        for (int g = 0; g < NG; ++g) {
            const int kr = kb - g;
            if (kr >= -2 && kr <= 2) {
                f32x16 st;
#pragma unroll
                for (int i = 0; i < 16; ++i) st[i] = 0.f;
#pragma unroll
                for (int ks = 0; ks < 4; ++ks) st = mfma32(kf[ks], qf[g][ks], st);
                if (kr == -2) {
#pragma unroll
                    for (int i = 0; i < 16; ++i) { const int jj = 8 * (i >> 2) + 4 * h + (i & 3); if (jj < r) st[i] = -1e30f; }
                } else if (kr == 2) {
#pragma unroll
                    for (int i = 0; i < 16; ++i) { const int jj = 8 * (i >> 2) + 4 * h + (i & 3); if (jj > r) st[i] = -1e30f; }
                }
                float tm = max3f(st[0], st[1], st[2]);
#pragma unroll
                for (int i = 3; i < 15; i += 2) tm = max3f(tm, st[i], st[i + 1]);
                tm = swapmax32(max2f(tm, st[15]));
                const float mn = max2f(m[g], tm);
                const float alpha = fexp2(m[g] - mn);
                m[g] = mn;
                float rs = 0.f;
#pragma unroll
                for (int i = 0; i < 16; ++i) { st[i] = fexp2(st[i] - mn); rs += st[i]; }
                l[g] = l[g] * alpha + rs;
#pragma unroll
                for (int j = 0; j < 8; ++j) { pfg[g][0][j] = (h16)st[j]; pfg[g][1][j] = (h16)st[8 + j]; }
                if (__builtin_amdgcn_ballot_w64(alpha != 1.f) != 0) {
#pragma unroll
                    for (int i = 0; i < 16; ++i) { o[g][0][i] *= alpha; o[g][1][i] *= alpha; }
                }
            }
        }
#pragma unroll
        for (int db = 0; db < 2; ++db)
#pragma unroll
            for (int s2 = 0; s2 < 2; ++s2) {
                const h16x4 lo = tr16(vp + (16 * s2) * 192 + db * 64);
                const h16x4 hi = tr16(vp + (16 * s2 + 8) * 192 + db * 64);
                const h16x8 vf = {lo[0], lo[1], lo[2], lo[3], hi[0], hi[1], hi[2], hi[3]};
#pragma unroll
                for (int g = 0; g < NG; ++g) {
                    const int kr = kb - g;
                    if (kr >= -2 && kr <= 2) o[g][db] = mfma32(vf, pfg[g][s2], o[g][db]);
                }
            }
        asm volatile("s_waitcnt lgkmcnt(0)" ::: "memory");
    }
#undef BLOAD
#pragma unroll
    for (int g = 0; g < NG; ++g) {
        const float lt = swapsum32(l[g]);
        const float inv = 1.f / lt;
        if (!last) {
#pragma unroll
            for (int db = 0; db < 2; ++db)
#pragma unroll
                for (int g4 = 0; g4 < 4; ++g4) {
                    u32x2 w;
                    w[0] = pk2(o[g][db][4 * g4 + 0] * inv, o[g][db][4 * g4 + 1] * inv);
                    w[1] = pk2(o[g][db][4 * g4 + 2] * inv, o[g][db][4 * g4 + 3] * inv);
                    *(LAS u32x2*)(ost + tl[g] * 136 + (32 * db + 8 * g4 + 4 * h) * 2) = w;
                }
            if (h == 0) { mst[tl[g]] = m[g]; lst[tl[g]] = lt; }
        } else {
            const int tok = T0 + tl[g];
#pragma unroll
            for (int db = 0; db < 2; ++db)
#pragma unroll
                for (int g4 = 0; g4 < 4; ++g4) {
                    const int d0 = 32 * db + 8 * g4 + 4 * h;
                    const h16x4 gt = *(const h16x4*)(Z + (zo(gslot, tok) + d0));
                    u32x2 w;
                    w[0] = pk2(o[g][db][4 * g4 + 0] * inv * (float)gt[0], o[g][db][4 * g4 + 1] * inv * (float)gt[1]);
                    w[1] = pk2(o[g][db][4 * g4 + 2] * inv * (float)gt[2], o[g][db][4 * g4 + 3] * inv * (float)gt[3]);
                    *(u32x2*)(MIX + ((unsigned)tok * 1024u + head * 64 + d0)) = w;
                }
        }
    }
}

__device__ __forceinline__ void banded_phase(const Params& P, LAS unsigned char* lds, int tid_in) {
    const h16* __restrict__ Z = (const h16*)(P.ws + WS_Z);
    h16* __restrict__ MIX = (h16*)(P.ws + WS_MIX);
    int tid_ = tid_in; asm volatile("" : "+v"(tid_));
    const int tid = tid_, lane = tid & 63, wave = __builtin_amdgcn_readfirstlane(tid >> 6), r = lane & 31, h = lane >> 5;
    LAS unsigned char* ost = lds;
    LAS float* mst = (LAS float*)(lds + 69632);
    LAS float* lst = (LAS float*)(lds + 71680);
    LAS unsigned char* vl = lds + 73728 + wave * 6144;
    LAS unsigned char* kl = lds + 122880 + wave * 4608;
    const int i16 = r & 15, tq_ = i16 >> 2, tp_ = i16 & 3, tch = r >> 4;
    LAS const unsigned char* vp = vl + (4 * h + tq_) * 192 + (16 * tch + 4 * tp_) * 2;
#pragma unroll 1
    for (int u = blockIdx.x; u < 2560; u += gridDim.x) {
        const int sp = 159 - (u >> 4), head = u & 15;
        const int T0 = sp * 512;
        const int S = T0 < TP ? 2048 : 4096;
        const int seqbase = T0 & ~(S - 1), off0 = T0 - seqbase;
        banded_item<2>(Z, MIX, ost, mst, lst, vl, kl, vp, T0, seqbase, off0, S, 0, 0, 2 * wave, head, true, false, lane);
        __syncthreads();
        banded_item<2>(Z, MIX, ost, mst, lst, vl, kl, vp, T0, seqbase, off0, S >> 2, 2, wave & 3, 2 * (wave >> 2), head, false, false, lane);
        __syncthreads();
#pragma unroll 1
        for (int rd = 0; rd < 2; ++rd)
            banded_item<1>(Z, MIX, ost, mst, lst, vl, kl, vp, T0, seqbase, off0, S >> 4, 4, wave + 8 * rd, 0, head, false, true, lane);
        __syncthreads();
    }
}

#ifndef MK_SP2
#define MK_SP2 true
#endif
#ifndef MK_ALIGN
#define MK_ALIGN true
#endif
template <int LO, int HI>
__global__ void __launch_bounds__(NTHREADS, 2) fwd_kernel(Params P) {
    extern __shared__ __attribute__((aligned(16))) unsigned char lds_raw[];
    LAS unsigned char* lds = (LAS unsigned char*)lds_raw;
    constexpr int lo = LO, hi = HI;
    const int wave_s = __builtin_amdgcn_readfirstlane((int)(threadIdx.x >> 6));
#define MYTID() (wave_s * 64 + opaque_lane())
    unsigned char* ws = P.ws;
#ifdef ONLY_PHASE
#define IN(k) ((k) == ONLY_PHASE && lo <= (k) && (k) < hi)
#else
#define IN(k) (lo <= (k) && (k) < hi)
#endif
#define SEAM(k) do { if (IN(k) && IN((k) + 1)) { \
        if ((k) == 0) cg::this_grid().sync(); \
        else { \
            __syncthreads(); \
            if (MYTID() == 0) { \
                unsigned* ctr = (unsigned*)(ws + WS_BAR); \
                __builtin_amdgcn_fence(__ATOMIC_RELEASE, "agent"); \
                __hip_atomic_fetch_add(ctr, 1u, __ATOMIC_RELAXED, __HIP_MEMORY_SCOPE_AGENT); \
                const unsigned target = (unsigned)(k) * gridDim.x; \
                while (__hip_atomic_load(ctr, __ATOMIC_RELAXED, __HIP_MEMORY_SCOPE_AGENT) < target) __builtin_amdgcn_s_sleep(2); \
                __builtin_amdgcn_fence(__ATOMIC_ACQUIRE, "agent"); \
            } \
            __syncthreads(); \
        } } } while (0)
    if (IN(0)) p0_phase(P, lds, MYTID());
    SEAM(0);
    if (IN(1)) {
        pg8::Gemm g{(const pg8::bf16_t*)(ws + WS_XH), (const pg8::bf16_t*)(ws + WS_WIN0), TT, N0, DM};
        pg8::StaticOrder S; S.init(TT, N0, (int)gridDim.x, (int)blockIdx.x);
        EpiIn E{(h16*)(ws + WS_Z), N0, 0, (const float*)(ws + WS_SSQ0), P.in[5], P.in[6], P.in[7], P.in[8]};
        pg8::gemm_phase<EpiIn, pg8::StaticOrder, MK_ALIGN, MK_SP2>(lds, g, S, E, MYTID());
#if defined(MK_DUP_PHASE) && MK_DUP_PHASE == 1
        __syncthreads();
        pg8::gemm_phase<EpiIn, pg8::StaticOrder, MK_ALIGN, MK_SP2>(lds, g, S, E, MYTID());
#endif
    }
    SEAM(1);
#ifdef MK_EXP
    if (IN(2)) { dense_phase<MK_EXP>(P, lds, MYTID()); __syncthreads(); }
#endif
    if (IN(2)) dense_phase<0>(P, lds, MYTID());
#if defined(MK_DUP_PHASE) && MK_DUP_PHASE == 2
    if (IN(2)) { __syncthreads(); dense_phase<0>(P, lds, MYTID()); }
#endif
    SEAM(2);
    if (IN(3)) {
        pg8::Gemm g{(const pg8::bf16_t*)(ws + WS_MIX), (const pg8::bf16_t*)(ws + WS_WOUT0), TT, DM, DM};
        pg8::StaticOrder S; S.init(TT, DM, (int)gridDim.x, (int)blockIdx.x);
        EpiOut0 E{P.in[0], P.in[1], (h16*)(ws + WS_XH), (float*)(ws + WS_SSQ1)};
        pg8::gemm_phase<EpiOut0, pg8::StaticOrder, MK_ALIGN, MK_SP2>(lds, g, S, E, MYTID());
    }
    SEAM(3);
    if (IN(4)) {
        pg8::Gemm g{(const pg8::bf16_t*)(ws + WS_XH), (const pg8::bf16_t*)(ws + WS_WIN1), TT, N1, DM};
        pg8::StaticOrder S; S.init(TT, N1, (int)gridDim.x, (int)blockIdx.x);
        EpiIn E{(h16*)(ws + WS_Z), N1, 1, (const float*)(ws + WS_SSQ1), P.in[17], P.in[18], P.in[17], P.in[18]};
        pg8::gemm_phase<EpiIn, pg8::StaticOrder, MK_ALIGN, MK_SP2>(lds, g, S, E, MYTID());
    }
    SEAM(4);
    if (IN(5)) banded_phase(P, lds, MYTID());
#if defined(MK_DUP_PHASE) && MK_DUP_PHASE == 5
    if (IN(5)) { __syncthreads(); banded_phase(P, lds, MYTID()); }
#endif
    SEAM(5);
    if (IN(6)) {
        pg8::Gemm g{(const pg8::bf16_t*)(ws + WS_MIX), (const pg8::bf16_t*)(ws + WS_WOUT1), TT, DM, DM};
        pg8::StaticOrder S; S.init(TT, DM, (int)gridDim.x, (int)blockIdx.x);
        EpiOut1 E{(const h16*)(ws + WS_XH), P.out};
        pg8::gemm_phase<EpiOut1, pg8::StaticOrder, MK_ALIGN, MK_SP2>(lds, g, S, E, MYTID());
    }
#undef IN
#undef SEAM
}

#ifndef MK_LAUNCHES
#define MK_LAUNCHES 1
#endif
template <int LO, int HI>
static void launch_range(const Params& p0, int grid, hipStream_t stream, bool coop) {
    Params p = p0; p.ph_lo = LO; p.ph_hi = HI;
    if (coop) {
        void* args[] = {&p};
        hipError_t e = hipLaunchCooperativeKernel((const void*)fwd_kernel<LO, HI>, dim3(grid), dim3(NTHREADS), args, LDS_BYTES, stream);
        if (e != hipSuccess) fprintf(stderr, "cooperative launch failed: %s (grid %d)\n", hipGetErrorString(e), grid);
    } else {
        hipLaunchKernelGGL((fwd_kernel<LO, HI>), dim3(grid), dim3(NTHREADS), LDS_BYTES, stream, p);
    }
}
template <int LO, int HI>
static bool prep_kernel(int& per_cu) {
    if (hipFuncSetAttribute((const void*)fwd_kernel<LO, HI>, hipFuncAttributeMaxDynamicSharedMemorySize, LDS_BYTES) != hipSuccess) { fprintf(stderr, "kernel_launch: hipFuncSetAttribute failed\n"); return false; }
    int pc = 0;
    if (hipOccupancyMaxActiveBlocksPerMultiprocessor(&pc, (const void*)fwd_kernel<LO, HI>, NTHREADS, LDS_BYTES) != hipSuccess || pc < 1) { fprintf(stderr, "kernel_launch: occupancy query gave %d\n", pc); pc = 1; (void)hipGetLastError(); }
    if (pc < per_cu) per_cu = pc;
    return true;
}
extern "C" void kernel_launch(void* const* d_in, const int* in_sizes, int n_in, void* d_out, int out_size, void* d_ws, size_t ws_size, hipStream_t stream) {
    static int grid = 0;
    if (grid == 0) {
        int dev = 0, cus = 0, per_cu = 64;
        if (hipGetDevice(&dev) != hipSuccess || hipDeviceGetAttribute(&cus, hipDeviceAttributeMultiprocessorCount, dev) != hipSuccess) { fprintf(stderr, "kernel_launch: device query failed\n"); grid = -1; return; }
        bool ok = true;
#if MK_LAUNCHES == 1
        ok = prep_kernel<0, 7>(per_cu);
#else
        ok = prep_kernel<0, 1>(per_cu) && prep_kernel<1, 2>(per_cu) && prep_kernel<2, 3>(per_cu) && prep_kernel<3, 4>(per_cu) && prep_kernel<4, 5>(per_cu) && prep_kernel<5, 6>(per_cu) && prep_kernel<6, 7>(per_cu);
#endif
        if (!ok) { grid = -1; return; }
        grid = cus * per_cu;
        if (ws_size < WS_END) fprintf(stderr, "kernel_launch: workspace too small: %zu < %zu\n", ws_size, (size_t)WS_END);
    }
    if (grid < 0) return;
    Params p{};
    for (int i = 0; i < 19; ++i) p.in[i] = (const float*)d_in[i];
    p.out = (float*)d_out; p.ws = (unsigned char*)d_ws;
    for (int j = 0; j < 8; ++j) p.frq[j] = pow(500000.0, -(double)(2 * j) / 16.0);
    for (int j = 0; j < 16; ++j) p.frq[8 + j] = pow(10000.0, -(double)(2 * j) / 32.0);
#if MK_LAUNCHES == 1
    (void)hipMemsetAsync((unsigned char*)d_ws + WS_BAR, 0, 256, stream);
    launch_range<0, 7>(p, grid, stream, true);
#else
    launch_range<0, 1>(p, grid, stream, false); launch_range<1, 2>(p, grid, stream, false); launch_range<2, 3>(p, grid, stream, false); launch_range<3, 4>(p, grid, stream, false);
    launch_range<4, 5>(p, grid, stream, false); launch_range<5, 6>(p, grid, stream, false); launch_range<6, 7>(p, grid, stream, false);
#endif
}
```
